# Optimizing an MI355X kernel written in HIP

```python
import jax, jax.numpy as jnp
from jax import lax
import numpy as np

D_MODEL = 2048
BATCH = 8
SEQ = 2048
DEPTH = 2

MEM_LEN = 256
GLA_HEADS = 4
GLA_DK = 128
GLA_DV = 256
GLA_GATE_RANK = 16
GLA_TAU = 16.0
GLA_CHUNK = 64
NSA_HEADS = 16
NSA_GROUPS = 4
NSA_HPG = NSA_HEADS // NSA_GROUPS
NSA_DH = 64
CMP_LEN = 32
CMP_STRIDE = 16
CMP_HIDDEN = 256
SEL_LEN = 64
SEL_TOPN = 8
WINDOW = 512
Q_BLOCK = 128
SEL_Q_BLOCK = 64
XA_HEADS = 4
XA_DH = 128
N_EXPERTS = 16
N_GROUPS = 4
EXPERTS_PER_GROUP = N_EXPERTS // N_GROUPS
TOP_K = 2
D_FF = 1536
MOE_BLOCK = 256
DN_ALPHA = float((2 * DEPTH) ** 0.25)
DN_BETA = float((8 * DEPTH) ** -0.25)
LN_EPS = 1e-5
NEG = -1e30
FORCE_BONUS = 1e6

GLA_QK = GLA_HEADS * GLA_DK
GLA_V = GLA_HEADS * GLA_DV
NSA_Q = NSA_HEADS * NSA_DH
NSA_KV = NSA_GROUPS * NSA_DH
IN_SPLITS = (GLA_QK, GLA_QK, GLA_V, GLA_V, GLA_GATE_RANK, NSA_Q, 6 * NSA_KV, 3 * NSA_HEADS, 2 * D_MODEL)
D_IN = sum(IN_SPLITS)
SPLIT_IDX = tuple(int(v) for v in np.cumsum(IN_SPLITS)[:-1])

kernel_name = "hybrid_gla_nsa_moe_deepnorm"


def layer_norm(x, g, b):
    xf = x.astype(jnp.float32)
    mu = jnp.mean(xf, -1, keepdims=True)
    var = jnp.mean(jnp.square(xf - mu), -1, keepdims=True)
    return ((xf - mu) * lax.rsqrt(var + LN_EPS)).astype(x.dtype) * g + b


def alibi_slopes(n):
    return 2.0 ** (-8.0 * jnp.arange(1, n + 1, dtype=jnp.float32) / n)


def gla_mixer(q, k, v, r, a_low, w_a2, b_a, norm_g):
    B, T, _ = q.shape
    H, C = GLA_HEADS, GLA_CHUNK
    N = T // C
    f32 = jnp.float32
    log_a = jax.nn.log_sigmoid((a_low @ w_a2 + b_a).astype(f32)) / GLA_TAU

    def chunks(t, d):
        return t.astype(f32).reshape(B, N, C, H, d).transpose(1, 0, 3, 2, 4)

    qc = chunks(q, GLA_DK) * (GLA_DK ** -0.5)
    kc = chunks(k, GLA_DK)
    vc = chunks(v, GLA_DV)
    gc = chunks(log_a, GLA_DK)
    causal = jnp.tril(jnp.ones((C, C), dtype=bool))[:, :, None]

    def step(S, inp):
        qi, ki, vi, gi = inp
        b = jnp.cumsum(gi, axis=2)
        b_last = b[:, :, -1, :]
        o_inter = jnp.einsum('bhtd,bhdv->bhtv', qi * jnp.exp(b), S)
        rel = jnp.exp(jnp.where(causal, b[:, :, :, None, :] - b[:, :, None, :, :], -jnp.inf))
        att = jnp.einsum('bhtd,bhsd,bhtsd->bhts', qi, ki, rel)
        o_intra = jnp.einsum('bhts,bhsv->bhtv', att, vi)
        S = jnp.exp(b_last)[..., None] * S + jnp.einsum(
            'bhsd,bhsv->bhdv', ki * jnp.exp(b_last[:, :, None, :] - b), vi)
        return S, o_inter + o_intra

    S0 = jnp.zeros((B, H, GLA_DK, GLA_DV), f32)
    _, o = lax.scan(step, S0, (qc, kc, vc, gc))
    o = o.transpose(1, 0, 3, 2, 4).reshape(B, T, H, GLA_DV)
    mu = jnp.mean(o, -1, keepdims=True)
    var = jnp.mean(jnp.square(o - mu), -1, keepdims=True)
    o = (o - mu) * lax.rsqrt(var + LN_EPS) * norm_g.reshape(H, GLA_DV)
    return (o.reshape(B, T, GLA_V) * jax.nn.silu(r.astype(f32))).astype(q.dtype)


def nsa_mixer(q, kv, gate_logits, cmp_pe, cmp_w1, cmp_w2):
    B, T, _ = q.shape
    G, HPG, DH = NSA_GROUPS, NSA_HPG, NSA_DH
    f32 = jnp.float32
    q = q.astype(f32).reshape(B, T, G, HPG, DH).transpose(0, 2, 3, 1, 4) * (DH ** -0.5)
    kv = kv.astype(f32).reshape(B, T, 6, G, DH).transpose(2, 0, 3, 1, 4)
    k_c, v_c, k_s, v_s, k_w, v_w = kv[0], kv[1], kv[2], kv[3], kv[4], kv[5]
    slope = alibi_slopes(NSA_HEADS).reshape(G, HPG)[None, :, :, None, None]
    pos = jnp.arange(T)

    n_cmp = (T - CMP_LEN) // CMP_STRIDE + 1
    blk_start = jnp.arange(n_cmp) * CMP_STRIDE
    blk_idx = blk_start[:, None] + jnp.arange(CMP_LEN)[None, :]

    def compress(t, pe, w1, w2):
        blocks = t[:, :, blk_idx, :] + pe
        flat = blocks.reshape(B, G, n_cmp, CMP_LEN * DH)
        return jax.nn.gelu(flat @ w1) @ w2

    kc = compress(k_c, cmp_pe[0], cmp_w1[0], cmp_w2[0])
    vc = compress(v_c, cmp_pe[1], cmp_w1[1], cmp_w2[1])
    blk_end = blk_start + CMP_LEN - 1
    blk_center = blk_start.astype(f32) + 0.5 * (CMP_LEN - 1)
    s_c = jnp.einsum('bghtd,bgnd->bghtn', q, kc)
    s_c = s_c - slope * jnp.abs(pos[:, None].astype(f32) - blk_center[None, :])
    mask_c = blk_end[None, :] <= pos[:, None]
    p_c = jax.nn.softmax(jnp.where(mask_c, s_c, NEG), axis=-1) * mask_c
    o_cmp = jnp.einsum('bghtn,bgnd->bghtd', p_c, vc)

    n_sel = T // SEL_LEN
    sel_start = jnp.arange(n_sel) * SEL_LEN
    overlap = ((blk_start[:, None] < sel_start[None, :] + SEL_LEN)
               & (blk_start[:, None] + CMP_LEN > sel_start[None, :])).astype(f32)
    imp = jnp.einsum('bghtn,nj->bgtj', p_c, overlap)
    cur = pos // SEL_LEN
    jj = jnp.arange(n_sel)
    forced = (jj[None, :] == 0) | (jj[None, :] == cur[:, None]) | (jj[None, :] == cur[:, None] - 1)
    valid_blk = sel_start[None, :] <= pos[:, None]
    score = jnp.where(valid_blk, imp + jnp.where(forced, FORCE_BONUS, 0.0), NEG)
    top_n = min(SEL_TOPN, n_sel)
    top_val, sel_idx = lax.top_k(score, top_n)
    sel_ok = top_val > 0.5 * NEG
    ks_blk = k_s.reshape(B, G, n_sel, SEL_LEN, DH)
    vs_blk = v_s.reshape(B, G, n_sel, SEL_LEN, DH)
    b_ix = jnp.arange(B)[:, None, None, None]
    g_ix = jnp.arange(G)[None, :, None, None]

    def sel_block(i):
        t0 = i * SEL_Q_BLOCK
        qi = lax.dynamic_slice_in_dim(q, t0, SEL_Q_BLOCK, axis=3)
        idx_i = lax.dynamic_slice_in_dim(sel_idx, t0, SEL_Q_BLOCK, axis=2)
        ok_i = lax.dynamic_slice_in_dim(sel_ok, t0, SEL_Q_BLOCK, axis=2)
        kg = ks_blk[b_ix, g_ix, idx_i]
        vg = vs_blk[b_ix, g_ix, idx_i]
        tq = t0 + jnp.arange(SEL_Q_BLOCK)
        kpos = idx_i[..., None] * SEL_LEN + jnp.arange(SEL_LEN)
        dist = (tq[:, None, None] - kpos).astype(f32)
        s = jnp.einsum('bghqd,bgqnkd->bghqnk', qi, kg) - slope[..., None] * dist[:, :, None]
        mask = (ok_i[..., None] & (kpos <= tq[:, None, None]))[:, :, None]
        s = jnp.where(mask, s, NEG).reshape(B, G, HPG, SEL_Q_BLOCK, top_n * SEL_LEN)
        p = jax.nn.softmax(s, axis=-1)
        return jnp.einsum('bghqm,bgqmd->bghqd', p, vg.reshape(B, G, SEL_Q_BLOCK, top_n * SEL_LEN, DH))

    o_sel = lax.map(sel_block, jnp.arange(T // SEL_Q_BLOCK))
    o_sel = jnp.moveaxis(o_sel, 0, 3).reshape(B, G, HPG, T, DH)

    zpad = jnp.zeros((B, G, WINDOW, DH), f32)
    kw_pad = jnp.concatenate([zpad, k_w], axis=2)
    vw_pad = jnp.concatenate([zpad, v_w], axis=2)
    span = WINDOW + Q_BLOCK

    def win_block(i):
        t0 = i * Q_BLOCK
        qi = lax.dynamic_slice_in_dim(q, t0, Q_BLOCK, axis=3)
        kb = lax.dynamic_slice_in_dim(kw_pad, t0, span, axis=2)
        vb = lax.dynamic_slice_in_dim(vw_pad, t0, span, axis=2)
        tq = t0 + jnp.arange(Q_BLOCK)
        tk = t0 - WINDOW + jnp.arange(span)
        d = tq[:, None] - tk[None, :]
        mask = (d >= 0) & (d < WINDOW) & (tk[None, :] >= 0)
        s = jnp.einsum('bghqd,bgkd->bghqk', qi, kb) - slope * d.astype(f32)
        p = jax.nn.softmax(jnp.where(mask, s, NEG), axis=-1)
        return jnp.einsum('bghqk,bgkd->bghqd', p, vb)

    o_win = lax.map(win_block, jnp.arange(T // Q_BLOCK))
    o_win = jnp.moveaxis(o_win, 0, 3).reshape(B, G, HPG, T, DH)

    gt = jax.nn.sigmoid(gate_logits.astype(f32)).reshape(B, T, G, HPG, 3).transpose(0, 2, 3, 1, 4)
    o = gt[..., 0:1] * o_cmp + gt[..., 1:2] * o_sel + gt[..., 2:3] * o_win
    return o.transpose(0, 3, 1, 2, 4).reshape(B, T, NSA_Q).astype(gate_logits.dtype)


def memory_xattn(x, mem, wq, wkv, wo):
    B, T, _ = x.shape
    M = mem.shape[1]
    q = (x @ wq).reshape(B, T, XA_HEADS, XA_DH) * (XA_DH ** -0.5)
    kv = (mem @ wkv).reshape(B, M, 2, XA_HEADS, XA_DH)
    s = jnp.einsum('bthd,bmhd->bhtm', q, kv[:, :, 0]).astype(jnp.float32)
    p = jax.nn.softmax(s, axis=-1).astype(x.dtype)
    o = jnp.einsum('bhtm,bmhd->bthd', p, kv[:, :, 1]).reshape(B, T, XA_HEADS * XA_DH)
    return o @ wo


def moe_ffn(x, router_w, router_b, w_in, w_down):
    B, T, D = x.shape
    N = B * T
    xt = x.reshape(N, D)
    logits = (xt @ router_w).astype(jnp.float32)
    grp = (logits + router_b.astype(jnp.float32)).reshape(N, N_GROUPS, EXPERTS_PER_GROUP)
    grp_score = lax.top_k(grp, TOP_K)[0].sum(-1)
    g_best = jnp.argmax(grp_score, axis=-1)
    in_grp = grp[jnp.arange(N), g_best]
    _, local = lax.top_k(in_grp, TOP_K)
    expert = g_best[:, None] * EXPERTS_PER_GROUP + local
    gate = jax.nn.softmax(jnp.take_along_axis(logits, expert, axis=1), axis=-1)

    M = N * TOP_K
    e_flat = expert.reshape(M)
    tok = jnp.repeat(jnp.arange(N), TOP_K)
    order = jnp.argsort(e_flat)
    e_sorted = e_flat[order]
    tok_sorted = tok[order]
    w_sorted = gate.reshape(M)[order]
    counts = jnp.bincount(e_flat, length=N_EXPERTS)
    padded = (counts + MOE_BLOCK - 1) // MOE_BLOCK * MOE_BLOCK
    pad_end = jnp.cumsum(padded)
    pad_start = pad_end - padded
    raw_start = jnp.cumsum(counts) - counts
    dest = pad_start[e_sorted] + jnp.arange(M) - raw_start[e_sorted]
    n_blocks = -(-M // MOE_BLOCK) + N_EXPERTS
    P = n_blocks * MOE_BLOCK
    buf = jnp.zeros((P, D), x.dtype).at[dest].set(xt[tok_sorted])
    blk_expert = jnp.clip(jnp.searchsorted(pad_end, jnp.arange(n_blocks) * MOE_BLOCK, side='right'),
                          0, N_EXPERTS - 1)

    def expert_block(args):
        xb, e = args
        a, u = jnp.split(xb @ w_in[e], 2, axis=-1)
        return (jax.nn.silu(a) * u) @ w_down[e]

    y_buf = lax.map(expert_block, (buf.reshape(n_blocks, MOE_BLOCK, D), blk_expert)).reshape(P, D)
    y = y_buf[dest] * w_sorted[:, None].astype(x.dtype)
    return jnp.zeros((N, D), x.dtype).at[tok_sorted].add(y).reshape(B, T, D)


def setup_inputs(seed: int = 0) -> dict:
    key = jax.random.key(seed)
    ks = jax.random.split(key, 25)
    L, D, E = DEPTH, D_MODEL, N_EXPERTS
    f32 = jnp.float32

    def nrm(k, shape, fan_in, scale=1.0):
        return jax.random.normal(k, shape, f32) * (scale * fan_in ** -0.5)

    def gain(k, shape):
        return 1.0 + 0.02 * jax.random.normal(k, shape, f32)

    def small(k, shape, s=0.01):
        return s * jax.random.normal(k, shape, f32)

    return {
        "x": jax.random.normal(ks[0], (BATCH, SEQ, D), f32),
        "mem": jax.random.normal(ks[1], (BATCH, MEM_LEN, D), f32),
        "w_in": nrm(ks[2], (L, D, D_IN), D),
        "gla_w_a2": nrm(ks[3], (L, GLA_GATE_RANK, GLA_QK), GLA_GATE_RANK),
        "gla_b_a": small(ks[4], (L, GLA_QK), 0.1),
        "gla_norm_g": gain(ks[5], (L, GLA_V)),
        "nsa_cmp_pe": small(ks[6], (L, 2, CMP_LEN, NSA_DH), 0.02),
        "nsa_cmp_w1": nrm(ks[7], (L, 2, CMP_LEN * NSA_DH, CMP_HIDDEN), CMP_LEN * NSA_DH),
        "nsa_cmp_w2": nrm(ks[8], (L, 2, CMP_HIDDEN, NSA_DH), CMP_HIDDEN),
        "w_branch_gla": nrm(ks[9], (L, GLA_V, D), GLA_V),
        "w_branch_nsa": nrm(ks[10], (L, NSA_Q, D), NSA_Q),
        "w_out": nrm(ks[11], (L, D, D), D, DN_BETA),
        "ln_mix_g": gain(ks[12], (L, D)),
        "ln_mix_b": small(ks[13], (L, D)),
        "xa_wq": nrm(ks[14], (L, D, XA_HEADS * XA_DH), D),
        "xa_wkv": nrm(ks[15], (L, D, 2 * XA_HEADS * XA_DH), D),
        "xa_wo": nrm(ks[16], (L, XA_HEADS * XA_DH, D), XA_HEADS * XA_DH, DN_BETA),
        "ln_xa_g": gain(ks[17], (L, D)),
        "ln_xa_b": small(ks[18], (L, D)),
        "router_w": nrm(ks[19], (D, E), D),
        "router_b": small(ks[20], (E,)),
        "moe_w_in": nrm(ks[21], (L, E, D, 2 * D_FF), D),
        "moe_w_down": nrm(ks[22], (L, E, D_FF, D), D_FF, DN_BETA),
        "ln_ffn_g": gain(ks[23], (L, D)),
        "ln_ffn_b": small(ks[24], (L, D)),
    }


def reference(x, mem, w_in, gla_w_a2, gla_b_a, gla_norm_g, nsa_cmp_pe, nsa_cmp_w1, nsa_cmp_w2,
              w_branch_gla, w_branch_nsa, w_out, ln_mix_g, ln_mix_b, xa_wq, xa_wkv, xa_wo,
              ln_xa_g, ln_xa_b, router_w, router_b, moe_w_in, moe_w_down, ln_ffn_g, ln_ffn_b):
    D = D_MODEL
    for l in range(DEPTH):
        h = x @ w_in[l]
        g_q, g_k, g_v, g_r, g_a, n_q, n_kv, n_g, m_g = jnp.split(h, SPLIT_IDX, axis=-1)
        o_gla = gla_mixer(g_q, g_k, g_v, g_r, g_a, gla_w_a2[l], gla_b_a[l], gla_norm_g[l])
        o_nsa = nsa_mixer(n_q, n_kv, n_g, nsa_cmp_pe[l], nsa_cmp_w1[l], nsa_cmp_w2[l])
        gates = jax.nn.sigmoid(m_g)
        merged = gates[..., :D] * (o_gla @ w_branch_gla[l]) + gates[..., D:] * (o_nsa @ w_branch_nsa[l])
        x = layer_norm(DN_ALPHA * x + merged @ w_out[l], ln_mix_g[l], ln_mix_b[l])
        x = layer_norm(DN_ALPHA * x + memory_xattn(x, mem, xa_wq[l], xa_wkv[l], xa_wo[l]),
                       ln_xa_g[l], ln_xa_b[l])
        x = layer_norm(DN_ALPHA * x + moe_ffn(x, router_w, router_b, moe_w_in[l], moe_w_down[l]),
                       ln_ffn_g[l], ln_ffn_b[l])
    return x
```

```cpp
#include <hip/hip_runtime.h>
#include <cstdio>
#include <cstdint>

#define LAS __attribute__((address_space(3)))
#define GAS __attribute__((address_space(1)))
typedef unsigned short bf16;
typedef short bf16x8 __attribute__((ext_vector_type(8)));
typedef float f32x4 __attribute__((ext_vector_type(4)));
typedef float f32x2 __attribute__((ext_vector_type(2)));
typedef unsigned u32x4 __attribute__((ext_vector_type(4)));
typedef unsigned u32x2 __attribute__((ext_vector_type(2)));
typedef int v8i32 __attribute__((ext_vector_type(8)));
typedef short s16x4 __attribute__((ext_vector_type(4)));

#define CONV_BLOCKS 96
#ifndef N_LAUNCH_MODE
#define N_LAUNCH_MODE 1
#endif

constexpr int D = 2048, BATCH = 8, SEQ = 2048, DEPTH = 2, M = BATCH * SEQ;
constexpr int MEM_LEN = 256;
constexpr int GLA_H = 4, GLA_DK = 128, GLA_DV = 256, GLA_RANK = 16, GLA_C = 64, GLA_NCH = SEQ / GLA_C;
constexpr int NSA_G = 4, NSA_DH = 64;
constexpr int N_EXP = 16, D_FF = 1536;
constexpr int D_IN = 9792, D_INP = 9984;
constexpr float DN_ALPHA = 1.4142135623730951f;
constexpr float LN_EPS = 1e-5f;
constexpr int MOE_MAXBLK = 144, MOE_P = MOE_MAXBLK * 256;

constexpr size_t MiB = 1u << 20;
constexpr size_t WS_CTL = 0, CTL_ZERO_BYTES = 1 * MiB;
constexpr size_t WS_W_IN = 2 * MiB;
constexpr size_t WS_W_BG = 80 * MiB;
constexpr size_t WS_W_BN = 88 * MiB;
constexpr size_t WS_W_OUT = 96 * MiB;
constexpr size_t WS_XA_WQ = 112 * MiB;
constexpr size_t WS_XA_WKV = 116 * MiB;
constexpr size_t WS_XA_WO = 124 * MiB;
constexpr size_t WS_CMP_W1 = 128 * MiB;
constexpr size_t WS_CMP_W2 = 132 * MiB;
constexpr size_t WS_CMP_B1 = 133 * MiB;
constexpr size_t WS_MOE_W1 = 134 * MiB;
constexpr size_t WS_MOE_W2 = 518 * MiB;
constexpr size_t WS_XB = 710 * MiB;
constexpr size_t WS_V = 774 * MiB;
constexpr size_t WS_XC = 902 * MiB;
constexpr size_t WS_GQ = 1030 * MiB;
constexpr size_t WS_GK = 1046 * MiB;
constexpr size_t WS_GV = 1062 * MiB;
constexpr size_t WS_GR = 1094 * MiB;
constexpr size_t WS_NQ = 1126 * MiB;
constexpr size_t WS_KC = 1158 * MiB;
constexpr size_t WS_KV4 = 1175 * MiB;
constexpr size_t WS_MG = 1207 * MiB;
constexpr size_t WS_GA = 1335 * MiB;
constexpr size_t WS_NG = 1336 * MiB;
constexpr size_t WS_UT = 1339 * MiB;
constexpr size_t WS_ST = 1467 * MiB;
constexpr size_t WS_DEC = 1531 * MiB;
constexpr size_t WS_OGLA = 1532 * MiB;
constexpr size_t WS_H1 = 1564 * MiB;
constexpr size_t WS_KCC = 1568 * MiB;
constexpr size_t WS_ONSA = 1569 * MiB;
constexpr size_t WS_M1 = 1601 * MiB;
constexpr size_t WS_XQ = 1665 * MiB;
constexpr size_t WS_XKV = 1681 * MiB;
constexpr size_t WS_MEMB = 1689 * MiB;
constexpr size_t WS_OXA = 1697 * MiB;
constexpr size_t WS_TOK = 1713 * MiB;
constexpr size_t WS_BUF = 1714 * MiB;
constexpr size_t WS_ACT = 1858 * MiB;
constexpr size_t WS_Y = 1966 * MiB;
constexpr size_t WS_XB8 = 2110 * MiB;
constexpr size_t WS_ST1 = 2142 * MiB;
constexpr size_t WS_ST2 = 2143 * MiB;
constexpr size_t WS_M8 = 2144 * MiB;
constexpr size_t WS_END = 2176 * MiB;

constexpr int CW_BAR = 4096;
constexpr int CW_CNT = 8192;
constexpr int CW_CONVQ = 8320;

constexpr int RING_BYTES = 131072;
constexpr int LDSCTL_OFF = RING_BYTES;
constexpr int MISC_OFF = LDSCTL_OFF + 320;
constexpr int MOETAB_OFF = LDSCTL_OFF + 512;
constexpr int PADST_OFF = LDSCTL_OFF + 1280;
constexpr int PTAB_OFF = LDSCTL_OFF + 2048;
constexpr int IPTAB_OFF = LDSCTL_OFF + 4096;
constexpr int ROWTOK_OFF = LDSCTL_OFF + 5120;
constexpr int LDS_BYTES = 147456;

__device__ __forceinline__ unsigned f2bf(float f) { unsigned u = __builtin_bit_cast(unsigned, f); return (u + 0x7fffu + ((u >> 16) & 1u)) >> 16; }
__device__ __forceinline__ float bf2f(unsigned h) { return __builtin_bit_cast(float, h << 16); }
__device__ __forceinline__ unsigned pk2(float lo, float hi) { return f2bf(lo) | (f2bf(hi) << 16); }
typedef __bf16 bf16x2_hw __attribute__((ext_vector_type(2)));
__device__ __forceinline__ unsigned cvt_pk_bf16(float lo, float hi) { const f32x2 v = {lo, hi}; return __builtin_bit_cast(unsigned, __builtin_convertvector(v, bf16x2_hw)); }
__device__ __forceinline__ u32x2 pk8_fp8(f32x4 a, f32x4 b) {
#pragma unroll
    for (int i = 0; i < 4; ++i) { a[i] = fminf(fmaxf(a[i], -448.f), 448.f); b[i] = fminf(fmaxf(b[i], -448.f), 448.f); }
    unsigned lo = 0u, hi = 0u;
    lo = (unsigned)__builtin_amdgcn_cvt_pk_fp8_f32(a[0], a[1], (int)lo, false); lo = (unsigned)__builtin_amdgcn_cvt_pk_fp8_f32(a[2], a[3], (int)lo, true);
    hi = (unsigned)__builtin_amdgcn_cvt_pk_fp8_f32(b[0], b[1], (int)hi, false); hi = (unsigned)__builtin_amdgcn_cvt_pk_fp8_f32(b[2], b[3], (int)hi, true);
    u32x2 r; r.x = lo; r.y = hi; return r;
}
__device__ __forceinline__ unsigned pk4_fp8(f32x4 a) {
#pragma unroll
    for (int i = 0; i < 4; ++i) a[i] = fminf(fmaxf(a[i], -448.f), 448.f);
    unsigned lo = 0u; lo = (unsigned)__builtin_amdgcn_cvt_pk_fp8_f32(a[0], a[1], (int)lo, false); lo = (unsigned)__builtin_amdgcn_cvt_pk_fp8_f32(a[2], a[3], (int)lo, true); return lo;
}
constexpr float W8_SCALE = 64.0f, W8_INV = 1.0f / 64.0f;
__device__ __forceinline__ f32x4 ld4_bf16(const bf16* p) { const u32x2 w = *(const u32x2*)p; return (f32x4){bf2f(w.x & 0xffffu), bf2f(w.x >> 16), bf2f(w.y & 0xffffu), bf2f(w.y >> 16)}; }
__device__ __forceinline__ void st4_bf16(bf16* p, f32x4 v) { u32x2 w; w.x = pk2(v[0], v[1]); w.y = pk2(v[2], v[3]); *(u32x2*)p = w; }
__device__ __forceinline__ float sigmoidf_(float x) { return 1.0f / (1.0f + __expf(-x)); }
__device__ __forceinline__ float siluf_(float x) { return x / (1.0f + __expf(-x)); }
__device__ __forceinline__ float gelu_tanh_(float x) { const float u = 1.5957691216057308f * (x + 0.044715f * x * x * x); return x / (1.0f + __expf(-u)); }
__device__ __forceinline__ float wave_sum(float v) {
#pragma unroll
    for (int o = 1; o < 64; o <<= 1) v += __shfl_xor(v, o);
    return v;
}
#define LDS_WAIT() asm volatile("s_waitcnt lgkmcnt(0)" ::: "memory")
#define VM_WAIT() asm volatile("s_waitcnt vmcnt(0)" ::: "memory")

namespace pg8 {
constexpr int BM = 256, BK = 64, HALF = 128, HTB = HALF * BK * 2, STAGE_BYTES = 8 * HTB, NXCD = 8, WGM = 8;
__host__ __device__ __forceinline__ int lds_byte(int r, int c) { const int st = (r >> 4) * 2 + (c >> 5), rr = r & 15, cc = c & 31, ob = rr * 64 + cc * 2; return st * 1024 + (ob ^ (((ob >> 9) & 1) << 5)); }
__host__ __device__ __forceinline__ void stage_rc(int b, int& R, int& C) { const int st = b / 1024, sb = b % 1024, swz = sb ^ (((sb >> 9) & 1) << 5); R = (st >> 1) * 16 + swz / 64; C = (st & 1) * 32 + (swz % 64) / 2; }
__host__ __device__ __forceinline__ int perm32(int rho) { const int n = rho >> 4, i = rho & 15; return 8 * (i >> 2) + 4 * n + (i & 3); }

struct Unit { int pm, pn, z; unsigned aoff, boff; };
struct Gemm { const bf16* A; const bf16* Bt; int lda, ldb, K; };

struct DenseOrder {
    static constexpr bool GATHER = false;
    int nM, nN, nZ, nwg, G, c, lda, ldb; unsigned azs, bzs;
    __device__ void init(int Mr, int Nc, int Z, int G_, int c_, int lda_, int ldb_, unsigned azs_, unsigned bzs_) { nM = Mr / BM; nN = Nc / BM; nZ = Z; nwg = nM * nN; G = G_; c = c_; lda = lda_; ldb = ldb_; azs = azs_; bzs = bzs_; }
    __device__ bool next(int i, Unit& u) const {
        const int L = i * G + c; if (c < 0 || L >= nwg * nZ) return false;
        const int z = L / nwg; int wgid = L % nwg;
        { const int q = nwg / NXCD, r = nwg % NXCD, xcd = wgid % NXCD, off = wgid / NXCD; wgid = (xcd < r ? xcd * (q + 1) : r * (q + 1) + (xcd - r) * q) + off; }
        const int nig = WGM * nN, gid = wgid / nig, fm = gid * WGM, gsz = (nM - fm) < WGM ? (nM - fm) : WGM;
        u.pm = fm + ((wgid % nig) % gsz); u.pn = (wgid % nig) / gsz; u.z = z;
        u.aoff = (unsigned)z * azs + (unsigned)u.pm * (unsigned)(BM * 2) * (unsigned)lda; u.boff = (unsigned)z * bzs + (unsigned)u.pn * (unsigned)(BM * 2) * (unsigned)ldb; return true;
    }
};
struct InProjOrder {
    static constexpr bool GATHER = false;
    DenseOrder d; int extra; unsigned a0, b0, a1, b1;
    __device__ bool next(int i, Unit& u) const {
        const int L = i * d.G + d.c;
        if (L < d.nwg) { const bool ok = d.next(i, u); u.aoff += a0; u.boff += b0; return ok; }
        const int e = L - d.nwg; if (e >= extra) return false;
        const int z = e >> 5, r = e & 31, pm = r & 7, pq = r >> 3;
        u.pm = pm; u.pn = 39 + z * 4 + pq; u.z = 0; u.aoff = a1 + (unsigned)pm * (unsigned)(BM * D); u.boff = b1 + (unsigned)z * (unsigned)(1024 * D) + (unsigned)pq * (unsigned)(BM * D); return true;
    }
};
template <bool GATHER_>
struct MoeOrderT {
    static constexpr bool GATHER = GATHER_;
    const LAS int* tab; int nN, G, c, lda, ldb; unsigned bzs;
    __device__ bool next(int i, Unit& u) const {
        const int L = i * G + c; const int nblk = __builtin_amdgcn_readfirstlane(tab[0]); if (L >= nblk * nN) return false;
        const int blk = L / nN, pn = L % nN, e = __builtin_amdgcn_readfirstlane(tab[16 + blk]);
        u.pm = blk; u.pn = pn; u.z = e; u.aoff = GATHER ? 0u : (unsigned)blk * (unsigned)(BM * 2) * (unsigned)lda; u.boff = (unsigned)e * bzs + (unsigned)pn * (unsigned)(BM * 2) * (unsigned)ldb; return true;
    }
};
typedef MoeOrderT<false> MoeOrder;
typedef MoeOrderT<true> MoeGatherOrder;

template <class Epi, class Sched, bool ALIGN_EPI>
__device__ __forceinline__ void gemm_phase(LAS unsigned char* lds, const int tid, const Gemm g, const Sched& S, const Epi& E) {
    const int wid = __builtin_amdgcn_readfirstlane(tid >> 6), lane = tid & 63, wr = wid >> 2, wc = wid & 3, fr = lane & 15, fq = lane >> 4;
    const int nt = g.K / BK;
    unsigned voffA[2], voffB[2];
#pragma unroll
    for (int i = 0; i < 2; ++i) { int R, C; const int b_ = tid * 16 + i * 8192;
        if (Epi::F8) { const int r7 = (b_ >> 7) & 7, gp = (b_ >> 4) & 7; R = 8 * (b_ >> 10) + r7; C = 8 * (gp ^ (((r7 >> 1) & 1) | (((r7 >> 2) & 1) << 2))); }
        else stage_rc(b_, R, C);
        const int Rb = Epi::PERM ? ((R & ~31) + perm32(R & 31)) : R;
        voffA[i] = (unsigned)(R * g.lda + C) * 2u; voffB[i] = (unsigned)(Rb * g.ldb + C) * 2u; }
    const size_t kstep = (size_t)(BK * 2);
    const size_t hsA = (size_t)HALF * g.lda * 2, hsB = (size_t)HALF * g.ldb * 2;
    const unsigned ldsw = (unsigned)wid * 1024u;
    constexpr bool F8 = Epi::F8;
    const int f8x = ((fr >> 1) & 1) | (((fr >> 2) & 1) << 2);
    const int aoff = F8 ? 128 * (wr * 64 + fr) + 16 * ((2 * fq) ^ f8x) : lds_byte(wr * 64 + fr, fq * 8), boff = F8 ? 128 * (wc * 32 + fr) + 16 * ((2 * fq) ^ f8x) : lds_byte(wc * 32 + fr, fq * 8);
    const int aoff1 = F8 ? 128 * (wr * 64 + fr) + 16 * ((2 * fq + 1) ^ f8x) : aoff + 1024, boff1 = F8 ? 128 * (wc * 32 + fr) + 16 * ((2 * fq + 1) ^ f8x) : boff + 1024;
#define PG8_SA(b, h) (((b) * 2 + (h)) * HTB)
#define PG8_SB(b, h) ((4 + (b) * 2 + (h)) * HTB)
#define PG8_STAGE(bufoff, gbase, voff) do { _Pragma("unroll") for (int _i = 0; _i < 2; ++_i) \
        __builtin_amdgcn_global_load_lds((const unsigned*)((const char*)(gbase) + (voff)[_i]), (LAS unsigned*)(lds + (bufoff) + ldsw + _i * 8192), 16, 0, 0); } while (0)
    constexpr bool GA = Sched::GATHER;
    unsigned ga[4] = {0u, 0u, 0u, 0u};
    const int grow = 8 * wid + ((tid >> 3) & 7); const unsigned gcb = 16u * (unsigned)((tid & 7) ^ ((((tid >> 3) & 7) >> 1 & 1) | ((((tid >> 3) & 7) >> 2 & 1) << 2)));
#define PG8_GLOAD(uidx) do { const LAS unsigned* rt_ = (const LAS unsigned*)(lds + ROWTOK_OFF) + (uidx) * 256 + grow; ga[0] = rt_[0] + gcb; ga[1] = rt_[64] + gcb; ga[2] = rt_[128] + gcb; ga[3] = rt_[192] + gcb; } while (0)
#define PG8_STAGE_A(bufoff, gbase, h) do { if constexpr (GA) PG8_STAGE(bufoff, gbase, ga + 2 * (h)); else PG8_STAGE(bufoff, (gbase) + (h) * hsA, voffA); } while (0)
#define PG8_LD8(dst, p0, p1) do { const u32x4 x0_ = *(const LAS u32x4*)(p0), x1_ = *(const LAS u32x4*)(p1); dst = (v8i32){(int)x0_.x, (int)x0_.y, (int)x0_.z, (int)x0_.w, (int)x1_.x, (int)x1_.y, (int)x1_.z, (int)x1_.w}; } while (0)
#define PG8_LDA(dst, b, h) do { _Pragma("unroll") for (int m = 0; m < 4; ++m) PG8_LD8(dst[m], lds + PG8_SA(b, h) + aoff + m * 2048, lds + PG8_SA(b, h) + aoff1 + m * 2048); } while (0)
#define PG8_LDB(dst, b, h) do { _Pragma("unroll") for (int n = 0; n < 2; ++n) PG8_LD8(dst[n], lds + PG8_SB(b, h) + boff + n * 2048, lds + PG8_SB(b, h) + boff1 + n * 2048); } while (0)
#define PG8_LO(v) __builtin_bit_cast(bf16x8, __builtin_shufflevector(v, v, 0, 1, 2, 3))
#define PG8_HI(v) __builtin_bit_cast(bf16x8, __builtin_shufflevector(v, v, 4, 5, 6, 7))
#define PG8_MMA(ai, bj, At, Bt) do { __builtin_amdgcn_s_setprio(1); _Pragma("unroll") for (int m = 0; m < 4; ++m) _Pragma("unroll") for (int n = 0; n < 2; ++n) { \
        if constexpr (F8) asm volatile("s_nop 1\n\tv_mfma_scale_f32_16x16x128_f8f6f4 %0, %1, %2, %0, %3, %3 op_sel_hi:[0,0,0]" : "+v"(acc[ai][bj][m][n]) : "v"(Bt[n]), "v"(At[m]), "v"(one_scale)); \
        else { acc[ai][bj][m][n] = __builtin_amdgcn_mfma_f32_16x16x32_bf16(PG8_LO(Bt[n]), PG8_LO(At[m]), acc[ai][bj][m][n], 0, 0, 0); \
               acc[ai][bj][m][n] = __builtin_amdgcn_mfma_f32_16x16x32_bf16(PG8_HI(Bt[n]), PG8_HI(At[m]), acc[ai][bj][m][n], 0, 0, 0); } } \
        __builtin_amdgcn_s_setprio(0); } while (0)
#define PG8_WAIT_V(n) asm volatile("s_waitcnt vmcnt(" #n ")" ::: "memory")
#define PG8_WAIT_L(n) asm volatile("s_waitcnt lgkmcnt(" #n ")" ::: "memory")
#define PG8_BAR __builtin_amdgcn_s_barrier()
#define PG8_SCHED __builtin_amdgcn_sched_barrier(0)
    Unit cur, nxt; int ui = 0;
    if (!S.next(0, cur)) return;
    f32x4 acc[2][2][4][2];
#pragma unroll
    for (int a = 0; a < 2; ++a)
#pragma unroll
        for (int b = 0; b < 2; ++b)
#pragma unroll
            for (int m = 0; m < 4; ++m)
#pragma unroll
                for (int n = 0; n < 2; ++n) acc[a][b][m][n] = (f32x4){0.f, 0.f, 0.f, 0.f};
    const int one_scale = 0x7f7f7f7f;
    v8i32 At[4], B0[2], B1[2];
    const char* cA = (const char*)g.A + cur.aoff; const char* cB = (const char*)g.Bt + cur.boff;
    if constexpr (GA) PG8_GLOAD(0);
    PG8_STAGE(PG8_SB(0, 0), cB, voffB); PG8_STAGE(PG8_SB(0, 1), cB + hsB, voffB); PG8_STAGE_A(PG8_SA(0, 0), cA, 0); PG8_STAGE_A(PG8_SA(0, 1), cA, 1);
    if (wr == 1) PG8_BAR;
    PG8_WAIT_V(2); PG8_BAR;
    PG8_STAGE(PG8_SB(1, 0), cB + kstep, voffB); PG8_STAGE_A(PG8_SA(1, 0), cA + kstep, 0); PG8_STAGE(PG8_SB(1, 1), cB + hsB + kstep, voffB);
    PG8_WAIT_V(6); PG8_BAR;
    for (;;) {
        const bool has_next = S.next(ui + 1, nxt);
        const char* nA = has_next ? (const char*)g.A + nxt.aoff : cA; const char* nB = has_next ? (const char*)g.Bt + nxt.boff : cB;
        for (int t = 0; t < nt; t += 2) {
            const bool last = (t == nt - 2);
            const char* a1 = cA + (size_t)(t + 1) * kstep;
            const char* a2 = last ? nA : cA + (size_t)(t + 2) * kstep; const char* b2 = last ? nB : cB + (size_t)(t + 2) * kstep;
            const char* a3 = a2 + kstep; const char* b3 = b2 + kstep;
            PG8_LDB(B0, 0, 0); PG8_LDB(B1, 0, 1); PG8_SCHED; PG8_LDA(At, 0, 0); PG8_STAGE_A(PG8_SA(1, 1), a1, 1);
            if constexpr (GA) { if (last && has_next) PG8_GLOAD(ui + 1); }
            PG8_WAIT_V(8); PG8_WAIT_L(0); PG8_BAR; PG8_MMA(0, 0, At, B0); PG8_MMA(0, 1, At, B1); PG8_BAR; PG8_SCHED;
            PG8_LDA(At, 0, 1); PG8_STAGE(PG8_SB(0, 0), b2, voffB); PG8_STAGE(PG8_SB(0, 1), b2 + hsB, voffB); PG8_STAGE_A(PG8_SA(0, 0), a2, 0);
            PG8_WAIT_V(8); PG8_WAIT_L(0); PG8_BAR; PG8_MMA(1, 0, At, B0); PG8_MMA(1, 1, At, B1); PG8_BAR; PG8_SCHED;
            PG8_LDB(B0, 1, 0); PG8_LDB(B1, 1, 1); PG8_SCHED; PG8_LDA(At, 1, 0); PG8_STAGE_A(PG8_SA(0, 1), a2, 1);
            PG8_WAIT_V(8); PG8_WAIT_L(0); PG8_BAR; PG8_MMA(0, 0, At, B0); PG8_MMA(0, 1, At, B1); PG8_BAR; PG8_SCHED;
            PG8_LDA(At, 1, 1); PG8_STAGE(PG8_SB(1, 0), b3, voffB); PG8_STAGE(PG8_SB(1, 1), b3 + hsB, voffB); PG8_STAGE_A(PG8_SA(1, 0), a3, 0);
            PG8_WAIT_V(8); PG8_WAIT_L(0); PG8_BAR; PG8_MMA(1, 0, At, B0); PG8_MMA(1, 1, At, B1); PG8_BAR; PG8_SCHED;
        }
        if constexpr (ALIGN_EPI) { if (wr == 0) PG8_BAR; }
        asm volatile("s_nop 15\n\ts_nop 15" ::: "memory");
        { int lo_ = lane; asm volatile("" : "+v"(lo_)); E(acc, cur, wr, wc, lo_ & 15, lo_ >> 4); }
        if (!has_next) break;
#pragma unroll
        for (int a = 0; a < 2; ++a)
#pragma unroll
            for (int b = 0; b < 2; ++b)
#pragma unroll
                for (int m = 0; m < 4; ++m)
#pragma unroll
                    for (int n = 0; n < 2; ++n) acc[a][b][m][n] = (f32x4){0.f, 0.f, 0.f, 0.f};
        cur = nxt; cA = nA; cB = nB; ++ui;
        if constexpr (ALIGN_EPI) { if (wr == 1) PG8_BAR; }
    }
    PG8_WAIT_V(0);
    if constexpr (!ALIGN_EPI) { if (wr == 0) PG8_BAR; }
    PG8_BAR;
#undef PG8_SA
#undef PG8_SB
#undef PG8_STAGE
#undef PG8_STAGE_A
#undef PG8_GLOAD
#undef PG8_LDA
#undef PG8_LD8
#undef PG8_LO
#undef PG8_HI
#undef PG8_LDB
#undef PG8_MMA
#undef PG8_WAIT_V
#undef PG8_WAIT_L
#undef PG8_BAR
#undef PG8_SCHED
}

struct EpiBf16 {
    static constexpr bool PERM = true; static constexpr bool F8 = false;
    bf16* O; int ldc; long zstride; int ncols;
    __device__ __forceinline__ void operator()(const f32x4 (&acc)[2][2][4][2], const Unit& u, int wr, int wc, int fr, int fq) const {
        const int row0 = u.pm * BM + wr * 64 + fr, col0 = u.pn * BM + wc * 32 + 8 * fq; bf16* base = O + (long)u.z * zstride;
#pragma unroll
        for (int ai = 0; ai < 2; ++ai)
#pragma unroll
            for (int m = 0; m < 4; ++m) { bf16* rowp = base + (size_t)(row0 + ai * HALF + m * 16) * ldc + col0;
#pragma unroll
                for (int bj = 0; bj < 2; ++bj) { if (col0 + bj * HALF < ncols) { const f32x4 v0 = acc[ai][bj][m][0], v1 = acc[ai][bj][m][1];
                    u32x4 w; w.x = cvt_pk_bf16(v0[0], v0[1]); w.y = cvt_pk_bf16(v0[2], v0[3]); w.z = cvt_pk_bf16(v1[0], v1[1]); w.w = cvt_pk_bf16(v1[2], v1[3]);
                    *(u32x4*)(rowp + bj * HALF) = w; } } }
    }
};
struct EpiCmp2 {
    static constexpr bool PERM = true; static constexpr bool F8 = false;
    bf16* O;
    __device__ __forceinline__ void operator()(const f32x4 (&acc)[2][2][4][2], const Unit& u, int wr, int wc, int fr, int fq) const {
        if (wc >= 2) return;
        const int row0 = u.pm * BM + wr * 64 + fr, col0 = wc * 32 + 8 * fq; bf16* base = O + (size_t)u.z * 4096 * 64;
#pragma unroll
        for (int ai = 0; ai < 2; ++ai)
#pragma unroll
            for (int m = 0; m < 4; ++m) { const f32x4 v0 = acc[ai][0][m][0], v1 = acc[ai][0][m][1];
                u32x4 w; w.x = cvt_pk_bf16(v0[0], v0[1]); w.y = cvt_pk_bf16(v0[2], v0[3]); w.z = cvt_pk_bf16(v1[0], v1[1]); w.w = cvt_pk_bf16(v1[2], v1[3]);
                *(u32x4*)(base + (size_t)(row0 + ai * HALF + m * 16) * 64 + col0) = w; }
    }
};
struct EpiCmp1 {
    static constexpr bool PERM = true; static constexpr bool F8 = true;
    bf16* O; const float* bias;
    __device__ __forceinline__ void operator()(const f32x4 (&acc)[2][2][4][2], const Unit& u, int wr, int wc, int fr, int fq) const {
        const int row0 = u.pm * BM + wr * 64 + fr, col0 = wc * 32 + 8 * fq; bf16* base = O + (size_t)u.z * 4096 * 256; const float* bz = bias + u.z * 256;
#pragma unroll
        for (int ai = 0; ai < 2; ++ai)
#pragma unroll
            for (int m = 0; m < 4; ++m) { bf16* rowp = base + (size_t)(row0 + ai * HALF + m * 16) * 256 + col0;
#pragma unroll
                for (int bj = 0; bj < 2; ++bj) { f32x4 v0 = acc[ai][bj][m][0] * W8_INV + *(const f32x4*)(bz + col0 + bj * HALF), v1 = acc[ai][bj][m][1] * W8_INV + *(const f32x4*)(bz + col0 + bj * HALF + 4);
#pragma unroll
                    for (int j = 0; j < 4; ++j) { v0[j] = gelu_tanh_(v0[j]); v1[j] = gelu_tanh_(v1[j]); }
                    u32x4 w; w.x = cvt_pk_bf16(v0[0], v0[1]); w.y = cvt_pk_bf16(v0[2], v0[3]); w.z = cvt_pk_bf16(v1[0], v1[1]); w.w = cvt_pk_bf16(v1[2], v1[3]);
                    *(u32x4*)(rowp + bj * HALF) = w; } }
    }
};
struct EpiInProj {
    static constexpr bool PERM = true; static constexpr bool F8 = true;
    GAS unsigned char* ws; const LAS unsigned* tab;
    __device__ __forceinline__ void operator()(const f32x4 (&acc)[2][2][4][2], const Unit& u, int wr, int wc, int fr, int fq) const {
        const int pn = u.pn; const int row0 = u.pm * BM + wr * 64 + fr; const int cl = wc * 32 + 8 * fq;
        if (pn == 38) {
            if (cl < 64) {
#pragma unroll
                for (int ai = 0; ai < 2; ++ai)
#pragma unroll
                    for (int m = 0; m < 4; ++m) { const int row = row0 + ai * HALF + m * 16; f32x4 v0 = acc[ai][0][m][0] * W8_INV, v1 = acc[ai][0][m][1] * W8_INV;
                        if (cl < 16) { GAS float* p = (GAS float*)(ws + WS_GA) + (size_t)row * 16 + cl; *(GAS f32x4*)p = v0; *(GAS f32x4*)(p + 4) = v1; }
                        else { GAS float* p = (GAS float*)(ws + WS_NG) + (size_t)row * 48 + (cl - 16);
#pragma unroll
                            for (int j = 0; j < 4; ++j) { v0[j] = sigmoidf_(v0[j]); v1[j] = sigmoidf_(v1[j]); }
                            *(GAS f32x4*)p = v0; *(GAS f32x4*)(p + 4) = v1; } }
            }
            return;
        }
        const LAS unsigned* te = tab + 4 * pn;
        const unsigned olo = __builtin_amdgcn_readfirstlane(te[0]), ohi = __builtin_amdgcn_readfirstlane(te[1]); const int ld = __builtin_amdgcn_readfirstlane(te[2]), mode = __builtin_amdgcn_readfirstlane(te[3]);
        GAS bf16* base = (GAS bf16*)(ws + (((unsigned long long)ohi << 32) | olo)); const int col = 0;
#pragma unroll
        for (int ai = 0; ai < 2; ++ai)
#pragma unroll
            for (int m = 0; m < 4; ++m) { const int row = row0 + ai * HALF + m * 16;
#pragma unroll
                for (int bj = 0; bj < 2; ++bj) { f32x4 v0 = acc[ai][bj][m][0] * W8_INV, v1 = acc[ai][bj][m][1] * W8_INV; const int c = cl + bj * HALF;
                    if (mode == 1) {
#pragma unroll
                        for (int j = 0; j < 4; ++j) { v0[j] = siluf_(v0[j]); v1[j] = siluf_(v1[j]); } }
                    if (mode == 2) {
#pragma unroll
                        for (int j = 0; j < 4; ++j) { v0[j] = sigmoidf_(v0[j]); v1[j] = sigmoidf_(v1[j]); } }
                    u32x4 w; w.x = cvt_pk_bf16(v0[0], v0[1]); w.y = cvt_pk_bf16(v0[2], v0[3]); w.z = cvt_pk_bf16(v1[0], v1[1]); w.w = cvt_pk_bf16(v1[2], v1[3]);
                    GAS bf16* p;
                    if (mode == 3) { const int gg = c >> 6, dd = c & 63, bb = row >> 11, tt = row & 2047; *(GAS u32x2*)((GAS unsigned char*)base + (((size_t)bb * 4 + gg) * 2048 + tt) * 64 + dd) = pk8_fp8(v0, v1); }
                    else { p = base + (size_t)row * ld + col + c; __builtin_nontemporal_store(w, (GAS u32x4*)p); } } }
    }
};
template <int STEP> struct EpiMerge {
    static constexpr bool PERM = true; static constexpr bool F8 = true;
    bf16* M1; const bf16* MG; unsigned char* M8;
    __device__ __forceinline__ void operator()(const f32x4 (&acc)[2][2][4][2], const Unit& u, int wr, int wc, int fr, int fq) const {
        const int row0 = u.pm * BM + wr * 64 + fr, col0 = u.pn * BM + wc * 32 + 8 * fq;
#pragma unroll
        for (int ai = 0; ai < 2; ++ai)
#pragma unroll
            for (int m = 0; m < 4; ++m) { const int row = row0 + ai * HALF + m * 16;
#pragma unroll
                for (int bj = 0; bj < 2; ++bj) { const int c = col0 + bj * HALF;
                    const u32x4 gw = *(const u32x4*)(MG + (size_t)row * 4096 + (STEP - 1) * 2048 + c);
                    f32x4 v0 = acc[ai][bj][m][0] * W8_INV, v1 = acc[ai][bj][m][1] * W8_INV;
                    v0[0] *= bf2f(gw.x & 0xffffu); v0[1] *= bf2f(gw.x >> 16); v0[2] *= bf2f(gw.y & 0xffffu); v0[3] *= bf2f(gw.y >> 16);
                    v1[0] *= bf2f(gw.z & 0xffffu); v1[1] *= bf2f(gw.z >> 16); v1[2] *= bf2f(gw.w & 0xffffu); v1[3] *= bf2f(gw.w >> 16);
                    bf16* p = M1 + (size_t)row * 2048 + c;
                    if (STEP == 2) { const u32x4 pw = *(const u32x4*)p;
                        v0[0] += bf2f(pw.x & 0xffffu); v0[1] += bf2f(pw.x >> 16); v0[2] += bf2f(pw.y & 0xffffu); v0[3] += bf2f(pw.y >> 16);
                        v1[0] += bf2f(pw.z & 0xffffu); v1[1] += bf2f(pw.z >> 16); v1[2] += bf2f(pw.w & 0xffffu); v1[3] += bf2f(pw.w >> 16); }
                    if (STEP == 2) *(u32x2*)(M8 + (size_t)row * 2048 + c) = pk8_fp8(v0, v1);
                    else { u32x4 w; w.x = cvt_pk_bf16(v0[0], v0[1]); w.y = cvt_pk_bf16(v0[2], v0[3]); w.z = cvt_pk_bf16(v1[0], v1[1]); w.w = cvt_pk_bf16(v1[2], v1[3]);
                        *(u32x4*)p = w; } } }
    }
};
template <bool F8_, bool XBF> struct EpiResid {
    static constexpr bool PERM = false; static constexpr bool F8 = F8_;
    const void* X; bf16* V;
    __device__ __forceinline__ void operator()(const f32x4 (&acc)[2][2][4][2], const Unit& u, int wr, int wc, int fr, int fq) const {
        const int row0 = u.pm * BM + wr * 64 + fr, col0 = u.pn * BM + wc * 32 + 4 * fq;
#pragma unroll
        for (int ai = 0; ai < 2; ++ai)
#pragma unroll
            for (int m = 0; m < 4; ++m) { const size_t off = (size_t)(row0 + ai * HALF + m * 16) * D + col0;
#pragma unroll
                for (int bj = 0; bj < 2; ++bj)
#pragma unroll
                    for (int n = 0; n < 2; ++n) { const size_t o = off + bj * HALF + n * 16; const f32x4 xv = XBF ? ld4_bf16((const bf16*)X + o) : *(const f32x4*)((const float*)X + o); st4_bf16(V + o, xv * DN_ALPHA + acc[ai][bj][m][n] * (F8_ ? W8_INV : 1.0f)); }
                asm volatile("" ::: "memory"); }
    }
};
template <bool F8_> struct EpiResidLN {
    static constexpr bool PERM = false; static constexpr bool F8 = F8_;
    bf16* V; const f32x2* stats; const float* g; const float* b;
    __device__ __forceinline__ void operator()(const f32x4 (&acc)[2][2][4][2], const Unit& u, int wr, int wc, int fr, int fq) const {
        const int row0 = u.pm * BM + wr * 64 + fr, col0 = u.pn * BM + wc * 32 + 4 * fq;
#pragma unroll
        for (int ai = 0; ai < 2; ++ai)
#pragma unroll
            for (int m = 0; m < 4; ++m) { const int row = row0 + ai * HALF + m * 16; const size_t off = (size_t)row * D + col0; const f32x2 st = stats[row]; const float ra = st[1] * DN_ALPHA, ma = -st[0] * ra;
#pragma unroll
                for (int bj = 0; bj < 2; ++bj)
#pragma unroll
                    for (int n = 0; n < 2; ++n) { const int c = bj * HALF + n * 16; const f32x4 xv = ld4_bf16(V + off + c), gg = *(const f32x4*)(g + col0 + c), bb = *(const f32x4*)(b + col0 + c);
                        st4_bf16(V + off + c, (xv * ra + ma) * gg + bb * DN_ALPHA + acc[ai][bj][m][n] * (F8_ ? W8_INV : 1.0f)); }
                asm volatile("" ::: "memory"); }
    }
};
struct EpiMoe1 {
    static constexpr bool PERM = true; static constexpr bool F8 = true;
    unsigned char* ACT;
    __device__ __forceinline__ void operator()(const f32x4 (&acc)[2][2][4][2], const Unit& u, int wr, int wc, int fr, int fq) const {
        const int row0 = u.pm * BM + wr * 64 + fr, col0 = u.pn * HALF + wc * 32 + 8 * fq;
#pragma unroll
        for (int ai = 0; ai < 2; ++ai)
#pragma unroll
            for (int m = 0; m < 4; ++m) { unsigned char* p = ACT + (size_t)(row0 + ai * HALF + m * 16) * D_FF + col0;
                f32x4 a0 = acc[ai][0][m][0] * W8_INV, a1 = acc[ai][0][m][1] * W8_INV; const f32x4 u0 = acc[ai][1][m][0] * W8_INV, u1 = acc[ai][1][m][1] * W8_INV;
#pragma unroll
                for (int j = 0; j < 4; ++j) { a0[j] = siluf_(a0[j]) * u0[j]; a1[j] = siluf_(a1[j]) * u1[j]; }
                *(u32x2*)p = pk8_fp8(a0, a1); }
    }
};
struct EpiBf16F8 {
    static constexpr bool PERM = true; static constexpr bool F8 = true;
    bf16* O; int ldc;
    __device__ __forceinline__ void operator()(const f32x4 (&acc)[2][2][4][2], const Unit& u, int wr, int wc, int fr, int fq) const {
        const int row0 = u.pm * BM + wr * 64 + fr, col0 = u.pn * BM + wc * 32 + 8 * fq;
#pragma unroll
        for (int ai = 0; ai < 2; ++ai)
#pragma unroll
            for (int m = 0; m < 4; ++m) { bf16* rowp = O + (size_t)(row0 + ai * HALF + m * 16) * ldc + col0;
#pragma unroll
                for (int bj = 0; bj < 2; ++bj) { const f32x4 v0 = acc[ai][bj][m][0] * W8_INV, v1 = acc[ai][bj][m][1] * W8_INV;
                    u32x4 w; w.x = cvt_pk_bf16(v0[0], v0[1]); w.y = cvt_pk_bf16(v0[2], v0[3]); w.z = cvt_pk_bf16(v1[0], v1[1]); w.w = cvt_pk_bf16(v1[2], v1[3]);
                    *(u32x4*)(rowp + bj * HALF) = w; } }
    }
};
struct EpiMoe2 {
    static constexpr bool PERM = true; static constexpr bool F8 = true;
    unsigned char* O;
    __device__ __forceinline__ void operator()(const f32x4 (&acc)[2][2][4][2], const Unit& u, int wr, int wc, int fr, int fq) const {
        const int row0 = u.pm * BM + wr * 64 + fr, col0 = u.pn * BM + wc * 32 + 8 * fq;
#pragma unroll
        for (int ai = 0; ai < 2; ++ai)
#pragma unroll
            for (int m = 0; m < 4; ++m) { unsigned char* rowp = O + (size_t)(row0 + ai * HALF + m * 16) * D + col0;
#pragma unroll
                for (int bj = 0; bj < 2; ++bj) *(u32x2*)(rowp + bj * HALF) = pk8_fp8(acc[ai][bj][m][0] * W8_INV, acc[ai][bj][m][1] * W8_INV); }
    }
};
}

#define XB_TMO      128
#define XB_XCNT(j)  (256  + 64 * (j))
#define XB_XSUB(j)  (1280 + 64 * (j))
#define XB_XGEN(j)  (2304 + 64 * (j))
#define XB_TOP      3328
#define XB_TOPGEN   3392
#define XCD_BAR_WORDS 3456
#define XB_SPIN_CAP (1u << 18)

__device__ __forceinline__ unsigned xb_ld(unsigned* p)              { return __hip_atomic_load(p, __ATOMIC_RELAXED, __HIP_MEMORY_SCOPE_AGENT); }
__device__ __forceinline__ unsigned xb_add(unsigned* p, unsigned v) { return __hip_atomic_fetch_add(p, v, __ATOMIC_RELAXED, __HIP_MEMORY_SCOPE_AGENT); }
__device__ __forceinline__ unsigned xb_xcc_id() { return (unsigned)__builtin_amdgcn_s_getreg((3 << 11) | 20) & 0xFu; }
#define XB_SPIN(cond, bar) do { unsigned _sp = 0; while (cond) { __builtin_amdgcn_s_sleep(1); \
    if ((++_sp & 255u) == 0u) { if (xb_ld(&(bar)[XB_TMO])) break; if (_sp > XB_SPIN_CAP) { atomicAdd(&(bar)[XB_TMO], 1u); break; } } } } while (0)

struct XcdBarrier { unsigned* bar; unsigned x; volatile LAS unsigned* st; };

__device__ __forceinline__ XcdBarrier xcd_barrier_post(unsigned* bar, volatile LAS unsigned* st) {
    XcdBarrier b; b.bar = bar; b.x = xb_xcc_id(); b.st = st;
    if (threadIdx.x == 0) (void)xb_add(&bar[XB_XCNT(b.x)], 1u);
    return b;
}
__device__ __forceinline__ void xcd_barrier_complete(unsigned* bar, unsigned x, unsigned& nloc, unsigned& nx) {
    const unsigned G = gridDim.x * gridDim.y * gridDim.z;
    unsigned sum, cnt, mine, sp = 0u;
    for (;;) {
        sum = 0u; cnt = 0u; mine = 0u;
#pragma unroll
        for (unsigned j = 0; j < 16; ++j) { const unsigned c = xb_ld(&bar[XB_XCNT(j)]); sum += c; cnt += (c > 0u) ? 1u : 0u; mine = (j == x) ? c : mine; }
        if (sum == G) break;
        __builtin_amdgcn_s_sleep(1);
        if ((++sp & 255u) == 0u) { if (xb_ld(&bar[XB_TMO])) break; if (sp > XB_SPIN_CAP) { atomicAdd(&bar[XB_TMO], 1u); break; } }
    }
    nloc = mine > 0u ? mine : 1u; nx = cnt > 0u ? cnt : 1u;
}
__device__ __forceinline__ void xcd_barrier(const XcdBarrier& b) {
    asm volatile("s_waitcnt vmcnt(0)" ::: "memory");
    __syncthreads();
    if (threadIdx.x == 0) {
        unsigned* bar = b.bar;
        __builtin_amdgcn_s_waitcnt(0);
        unsigned nloc = b.st[0], nx = b.st[1];
        if (nloc == 0u) { xcd_barrier_complete(bar, b.x, nloc, nx); b.st[0] = nloc; b.st[1] = nx; }
        const unsigned old = xb_add(&bar[XB_XSUB(b.x)], 1u);
        const unsigned gen = old / nloc;
        if (old + 1u == (gen + 1u) * nloc) {
            __builtin_amdgcn_fence(__ATOMIC_RELEASE, "agent");
            asm volatile("s_waitcnt vmcnt(0)" ::: "memory");
            const unsigned og = xb_add(&bar[XB_TOP], 1u);
            const unsigned tg = og / nx;
            if (og + 1u == (tg + 1u) * nx) xb_add(&bar[XB_TOPGEN], 1u);
            else XB_SPIN(xb_ld(&bar[XB_TOPGEN]) == tg, bar);
            __builtin_amdgcn_fence(__ATOMIC_ACQUIRE, "agent");
            xb_add(&bar[XB_XGEN(b.x)], 1u);
            asm volatile("s_waitcnt vmcnt(0)" ::: "memory");
        } else {
            XB_SPIN(xb_ld(&bar[XB_XGEN(b.x)]) == gen, bar);
            __builtin_amdgcn_fence(__ATOMIC_ACQUIRE, "agent");
            asm volatile("s_waitcnt vmcnt(0)" ::: "memory");
        }
    }
    __syncthreads();
}

struct Args { const float* in[25]; float* out; unsigned char* ws; int ph_lo, ph_hi; };
enum { I_X = 0, I_MEM, I_WIN, I_WA2, I_BA, I_GNG, I_PE, I_CW1, I_CW2, I_WBG, I_WBN, I_WOUT, I_LNMG, I_LNMB, I_XWQ, I_XWKV, I_XWO, I_LNXG, I_LNXB, I_RW, I_RB, I_MW1, I_MW2, I_LNFG, I_LNFB };
constexpr int PH_CONV = 0, PH_PRE2 = 1, PH_L0 = 2, PH_PER_LAYER = 17, N_PHASES = PH_L0 + DEPTH * PH_PER_LAYER;
enum { LP_INPROJ = 0, LP_A, LP_B, LP_GLA3, LP_NSA, LP_BG, LP_BN, LP_WOUT, LP_LN1, LP_XQ, LP_XATT, LP_WO, LP_LN2R, LP_DISP, LP_MOE1, LP_MOE2, LP_COMB };

struct Frame {
    LAS unsigned char* lds;
    int tid, lane, wave, G, bid;
};

__device__ __forceinline__ int map_inproj(int s) {
    if (s < 3072) return s;
    if (s < 3088) return 9728 + (s - 3072);
    if (s < 4112) return 3072 + (s - 3088);
    if (s < 5648) return 4096 + (s - 4112);
    if (s < 5696) return 9744 + (s - 5648);
    return 5632 + (s - 5696);
}
__device__ __forceinline__ int map_moe1(int s) { return s < 1536 ? ((s >> 7) * 256 + (s & 127)) : (((s - 1536) >> 7) * 256 + 128 + ((s - 1536) & 127)); }
template <int MAP> __device__ __forceinline__ int map_col(int s) { return MAP == 1 ? map_inproj(s) : (MAP == 2 ? map_moe1(s) : s); }
template <int MAP> __device__ __forceinline__ float col_scale(int s) { return MAP == 1 ? (s < 512 ? 0.08838834764831845f : ((s >= 3088 && s < 4112) ? 0.125f * 1.4426950408889634f : 1.0f)) : (MAP == 3 ? 0.08838834764831845f * 1.4426950408889634f : 1.0f); }

template <int MAP>
__device__ __forceinline__ void transpose_item(const float* W, int K, int N, bf16* WT, LAS float* scr, int item, int lane) {
    const int nblk = N / 32, kb = item / nblk, nb = item % nblk, k0 = 64 * kb, n0 = 32 * nb;
#pragma unroll
    for (int i = 0; i < 32; ++i) { const int kk = 2 * i + (lane >> 5); scr[kk * 33 + (lane & 31)] = W[(size_t)(k0 + kk) * N + n0 + (lane & 31)]; }
    LDS_WAIT();
    const int c = lane & 7;
#pragma unroll
    for (int j = 0; j < 4; ++j) { const int n = (lane >> 3) + 8 * j; const LAS float* s = scr + (8 * c) * 33 + n; const float cs = col_scale<MAP>(n0 + n);
        u32x4 o; o.x = pk2(s[0 * 33] * cs, s[1 * 33] * cs); o.y = pk2(s[2 * 33] * cs, s[3 * 33] * cs); o.z = pk2(s[4 * 33] * cs, s[5 * 33] * cs); o.w = pk2(s[6 * 33] * cs, s[7 * 33] * cs);
        *(u32x4*)(WT + (size_t)map_col<MAP>(n0 + n) * K + k0 + 8 * c) = o; }
    LDS_WAIT();
}
template <int MAP>
__device__ __forceinline__ void transpose_item_f8(const float* W, int K, int N, unsigned char* WT, LAS float* scr, int item, int lane) {
    const int nblk = N / 32, kb = item / nblk, nb = item % nblk, k0 = 64 * kb, n0 = 32 * nb;
#pragma unroll
    for (int i = 0; i < 32; ++i) { const int kk = 2 * i + (lane >> 5); scr[kk * 33 + (lane & 31)] = W[(size_t)(k0 + kk) * N + n0 + (lane & 31)]; }
    LDS_WAIT();
    const int c = lane & 7;
#pragma unroll
    for (int j = 0; j < 4; ++j) { const int n = (lane >> 3) + 8 * j; const LAS float* s = scr + (8 * c) * 33 + n; const float cs = col_scale<MAP>(n0 + n) * W8_SCALE;
        const f32x4 a = {s[0 * 33] * cs, s[1 * 33] * cs, s[2 * 33] * cs, s[3 * 33] * cs}, b = {s[4 * 33] * cs, s[5 * 33] * cs, s[6 * 33] * cs, s[7 * 33] * cs};
        *(u32x2*)(WT + (size_t)map_col<MAP>(n0 + n) * K + k0 + 8 * c) = pk8_fp8(a, b); }
    LDS_WAIT();
}
template <int MAP>
__device__ __forceinline__ void transpose_job_f8(const Frame& F, const float* W, int K, int N, int nmat, unsigned char* WT, size_t dstride) {
    LAS float* scr = (LAS float*)(F.lds + F.wave * 16384);
    const int gw = F.bid * 8 + F.wave, NGW = F.G * 8;
    const int ipm = (K / 64) * (N / 32); const long total = (long)ipm * nmat;
    for (long it = gw; it < total; it += NGW) { const int mi = (int)(it / ipm), r = (int)(it % ipm);
        transpose_item_f8<MAP>(W + (size_t)mi * K * N, K, N, WT + (size_t)mi * dstride, scr, r, F.lane); }
}
__device__ __forceinline__ void cvt_rows_bf16(const Frame& F, const float* src, bf16* dst, size_t n) {
    const size_t nth = (size_t)F.G * 512, i0 = (size_t)F.bid * 512 + F.tid;
    for (size_t i = i0; i < n / 8; i += nth) { const f32x4 a = *(const f32x4*)(src + i * 8), b = *(const f32x4*)(src + i * 8 + 4);
        u32x4 w; w.x = pk2(a[0], a[1]); w.y = pk2(a[2], a[3]); w.z = pk2(b[0], b[1]); w.w = pk2(b[2], b[3]); *(u32x4*)(dst + i * 8) = w; }
}
__device__ __forceinline__ void zero_bf16(const Frame& F, bf16* dst, size_t n) {
    const size_t nth = (size_t)F.G * 512, i0 = (size_t)F.bid * 512 + F.tid;
    for (size_t i = i0; i < n / 8; i += nth) *(u32x4*)(dst + i * 8) = (u32x4){0u, 0u, 0u, 0u};
}

constexpr int CJ0 = 32 * 306, CJ1 = 2 * 16 * 64, CJ2 = CJ1, CJ3 = 2 * 32 * 64, CJ4 = 2 * 32 * 16, CJ5 = 2 * 8 * 64, CJ6 = 4 * 32 * 8, CJ7 = 4 * 4 * 2, CJ8 = DEPTH * N_EXP * 32 * 96, CJ9 = DEPTH * N_EXP * 24 * 64;
constexpr int CONV_ITEMS = CJ0 + CJ1 + CJ2 + CJ3 + CJ4 + CJ5 + CJ6 + CJ7 + CJ8 + CJ9, CONV_CHUNK = 32, CONV_NCHUNK = (CONV_ITEMS + CONV_CHUNK - 1) / CONV_CHUNK;
struct ConvSrc { const float *win, *wbg, *wbn, *wout, *xwq, *xwo, *cw1, *cw2, *mw1, *mw2; GAS unsigned char* ws; };
struct ConvDesc { const float* W; int K, N, item, job, mi; };
__device__ __forceinline__ ConvDesc conv_desc(const ConvSrc& c, int f) {
    ConvDesc d;
    if (f < CJ0) { d.W = c.win + (size_t)D * D_IN; d.K = D; d.N = D_IN; d.item = f; d.job = 0; d.mi = 0; return d; } f -= CJ0;
    if (f < CJ1) { d.mi = f / (CJ1 / 2); d.item = f % (CJ1 / 2); d.W = c.wbg + (size_t)d.mi * 1024 * D; d.K = 1024; d.N = D; d.job = 1; return d; } f -= CJ1;
    if (f < CJ2) { d.mi = f / (CJ2 / 2); d.item = f % (CJ2 / 2); d.W = c.wbn + (size_t)d.mi * 1024 * D; d.K = 1024; d.N = D; d.job = 2; return d; } f -= CJ2;
    if (f < CJ3) { d.mi = f / (CJ3 / 2); d.item = f % (CJ3 / 2); d.W = c.wout + (size_t)d.mi * D * D; d.K = D; d.N = D; d.job = 3; return d; } f -= CJ3;
    if (f < CJ4) { d.mi = f / (CJ4 / 2); d.item = f % (CJ4 / 2); d.W = c.xwq + (size_t)d.mi * D * 512; d.K = D; d.N = 512; d.job = 4; return d; } f -= CJ4;
    if (f < CJ5) { d.mi = f / (CJ5 / 2); d.item = f % (CJ5 / 2); d.W = c.xwo + (size_t)d.mi * 512 * D; d.K = 512; d.N = D; d.job = 5; return d; } f -= CJ5;
    if (f < CJ6) { d.mi = f / (CJ6 / 4); d.item = f % (CJ6 / 4); d.W = c.cw1 + (size_t)d.mi * 2048 * 256; d.K = 2048; d.N = 256; d.job = 6; return d; } f -= CJ6;
    if (f < CJ7) { d.mi = f / (CJ7 / 4); d.item = f % (CJ7 / 4); d.W = c.cw2 + (size_t)d.mi * 256 * 64; d.K = 256; d.N = 64; d.job = 7; return d; } f -= CJ7;
    if (f < CJ8) { d.mi = f / (32 * 96); d.item = f % (32 * 96); d.W = c.mw1 + (size_t)d.mi * D * 2 * D_FF; d.K = D; d.N = 2 * D_FF; d.job = 8; return d; } f -= CJ8;
    d.mi = f / (24 * 64); d.item = f % (24 * 64); d.W = c.mw2 + (size_t)d.mi * D_FF * D; d.K = D_FF; d.N = D; d.job = 9; return d;
}
struct TileRegs { f32x4 v[8]; };
__device__ __forceinline__ void tile_load(const ConvDesc& d, int lane, TileRegs& r) {
    const int nblk = d.N / 32, kb = d.item / nblk, nb = d.item % nblk, k0 = 64 * kb + 8 * (lane >> 3), n0 = 32 * nb + 4 * (lane & 7);
    const float* p = d.W + (size_t)k0 * d.N + n0;
#pragma unroll
    for (int i = 0; i < 8; ++i) r.v[i] = __builtin_nontemporal_load((const f32x4*)(p + (size_t)i * d.N));
}
template <int MAP, bool F8>
__device__ __forceinline__ void tile_store(const TileRegs& r, int K, int N, void* WTv, LAS float* scr, int item, int lane) {
    const int nblk = N / 32, kb = item / nblk, nb = item % nblk, k0 = 64 * kb + 8 * (lane >> 3), n = 32 * nb + 4 * (lane & 7);
    const float cs = col_scale<MAP>(n) * (F8 ? W8_SCALE : 1.0f);
    const size_t row = (size_t)map_col<MAP>(n);
    if (F8) { unsigned char* p = (unsigned char*)WTv + row * K + k0;
#pragma unroll
        for (int c = 0; c < 4; ++c) { unsigned lo = 0u, hi = 0u;
            lo = (unsigned)__builtin_amdgcn_cvt_pk_fp8_f32(r.v[0][c] * cs, r.v[1][c] * cs, (int)lo, false); lo = (unsigned)__builtin_amdgcn_cvt_pk_fp8_f32(r.v[2][c] * cs, r.v[3][c] * cs, (int)lo, true);
            hi = (unsigned)__builtin_amdgcn_cvt_pk_fp8_f32(r.v[4][c] * cs, r.v[5][c] * cs, (int)hi, false); hi = (unsigned)__builtin_amdgcn_cvt_pk_fp8_f32(r.v[6][c] * cs, r.v[7][c] * cs, (int)hi, true);
            u32x2 w; w.x = lo; w.y = hi; *(u32x2*)(p + (size_t)c * K) = w; } }
    else { bf16* p = (bf16*)WTv + row * K + k0;
#pragma unroll
        for (int c = 0; c < 4; ++c) { u32x4 w; w.x = pk2(r.v[0][c] * cs, r.v[1][c] * cs); w.y = pk2(r.v[2][c] * cs, r.v[3][c] * cs); w.z = pk2(r.v[4][c] * cs, r.v[5][c] * cs); w.w = pk2(r.v[6][c] * cs, r.v[7][c] * cs);
            *(u32x4*)(p + (size_t)c * K) = w; } }
}
template <int MAP, bool F8>
__device__ __forceinline__ void convert_job(const Frame& F, const float* W, int K, int N, int nmat, void* WT, size_t dstride) {
    const int gw = F.bid * 8 + F.wave, NGW = F.G * 8;
    const int ipm = (K / 64) * (N / 32); const long total = (long)ipm * nmat;
    for (long it = gw; it < total; it += NGW) { ConvDesc d; d.mi = (int)(it / ipm); d.item = (int)(it % ipm); d.W = W + (size_t)d.mi * K * N; d.K = K; d.N = N; d.job = 0;
        TileRegs r; tile_load(d, F.lane, r);
        tile_store<MAP, F8>(r, K, N, F8 ? (void*)((unsigned char*)WT + (size_t)d.mi * dstride) : (void*)((bf16*)WT + (size_t)d.mi * dstride), nullptr, d.item, F.lane); }
}
constexpr int CT0 = 16 * 39, CT1 = 2 * 8 * 8, CT2 = CT1, CT3 = 2 * 16 * 8, CT4 = 2 * 16 * 2, CT5 = 2 * 4 * 8, CT6 = 4 * 16 * 1, CT8 = DEPTH * N_EXP * 16 * 12, CT9 = DEPTH * N_EXP * 12 * 8;
constexpr int CT_TOTAL = CT0 + CT1 + CT2 + CT3 + CT4 + CT5 + CT6 + CT8 + CT9, CT_CHUNK = 2, CT_NCHUNK = (CT_TOTAL + CT_CHUNK - 1) / CT_CHUNK;
constexpr int CT_PITCH = 144;
struct CTile { const float* W; unsigned char* WT; int K, N, map, kb, nb; };
__device__ __forceinline__ void ctile_split(int f, int KB, int NB, int& mi, int& kb, int& nb) { mi = f / (KB * NB); const int r = f % (KB * NB); kb = r / NB; nb = r % NB; }
__device__ __forceinline__ CTile ctile_desc(const ConvSrc& c, int f) {
    CTile t; int mi;
    if (f < CT0) { ctile_split(f, 16, 39, mi, t.kb, t.nb); t.W = c.win + (size_t)D * D_IN; t.WT = (unsigned char*)(c.ws + WS_W_IN) + (size_t)D_INP * D; t.K = D; t.N = D_IN; t.map = 1; return t; } f -= CT0;
    if (f < CT1) { ctile_split(f, 8, 8, mi, t.kb, t.nb); t.W = c.wbg + (size_t)mi * 1024 * D; t.WT = (unsigned char*)(c.ws + WS_W_BG) + (size_t)mi * D * 1024; t.K = 1024; t.N = D; t.map = 0; return t; } f -= CT1;
    if (f < CT2) { ctile_split(f, 8, 8, mi, t.kb, t.nb); t.W = c.wbn + (size_t)mi * 1024 * D; t.WT = (unsigned char*)(c.ws + WS_W_BN) + (size_t)mi * D * 1024; t.K = 1024; t.N = D; t.map = 0; return t; } f -= CT2;
    if (f < CT3) { ctile_split(f, 16, 8, mi, t.kb, t.nb); t.W = c.wout + (size_t)mi * D * D; t.WT = (unsigned char*)(c.ws + WS_W_OUT) + (size_t)mi * D * D; t.K = D; t.N = D; t.map = 0; return t; } f -= CT3;
    if (f < CT4) { ctile_split(f, 16, 2, mi, t.kb, t.nb); t.W = c.xwq + (size_t)mi * D * 512; t.WT = (unsigned char*)(c.ws + WS_XA_WQ) + (size_t)mi * 512 * D; t.K = D; t.N = 512; t.map = 3; return t; } f -= CT4;
    if (f < CT5) { ctile_split(f, 4, 8, mi, t.kb, t.nb); t.W = c.xwo + (size_t)mi * 512 * D; t.WT = (unsigned char*)(c.ws + WS_XA_WO) + (size_t)mi * D * 512; t.K = 512; t.N = D; t.map = 0; return t; } f -= CT5;
    if (f < CT6) { ctile_split(f, 16, 1, mi, t.kb, t.nb); t.W = c.cw1 + (size_t)mi * 2048 * 256; t.WT = (unsigned char*)(c.ws + WS_CMP_W1) + (size_t)mi * 256 * 2048; t.K = 2048; t.N = 256; t.map = 0; return t; } f -= CT6;
    if (f < CT8) { ctile_split(f, 16, 12, mi, t.kb, t.nb); t.W = c.mw1 + (size_t)mi * D * 2 * D_FF; t.WT = (unsigned char*)(c.ws + WS_MOE_W1) + (size_t)mi * 2 * D_FF * D; t.K = D; t.N = 2 * D_FF; t.map = 2; return t; } f -= CT8;
    ctile_split(f, 12, 8, mi, t.kb, t.nb); t.W = c.mw2 + (size_t)mi * D_FF * D; t.WT = (unsigned char*)(c.ws + WS_MOE_W2) + (size_t)mi * D * D_FF; t.K = D_FF; t.N = D; t.map = 0; return t;
}
__device__ __forceinline__ int map_col_rt(int map, int s) { return map == 1 ? map_inproj(s) : (map == 2 ? map_moe1(s) : s); }
__device__ __forceinline__ float col_scale_rt(int map, int s) { return map == 1 ? col_scale<1>(s) : (map == 3 ? col_scale<3>(s) : 1.0f); }
__device__ __forceinline__ void ctile_load(const CTile& t, int wave, int lane, f32x4 (&v)[16]) {
    const int n = 256 * t.nb + 4 * lane; const bool ok = n < t.N;
    const float* p = t.W + (size_t)(128 * t.kb + 16 * wave) * t.N + n;
#pragma unroll
    for (int i = 0; i < 16; ++i) { v[i] = (f32x4){0.f, 0.f, 0.f, 0.f}; if (ok) v[i] = __builtin_nontemporal_load((const f32x4*)(p + (size_t)i * t.N)); }
}
__device__ __forceinline__ void ctile_store(const CTile& t, const f32x4 (&v)[16], LAS unsigned char* tile, int tid, int wave, int lane) {
    const float cs = col_scale_rt(t.map, 256 * t.nb + 4 * lane) * W8_SCALE;
#pragma unroll
    for (int c = 0; c < 4; ++c) { unsigned w[4];
#pragma unroll
        for (int j = 0; j < 4; ++j) { unsigned x = 0u; x = (unsigned)__builtin_amdgcn_cvt_pk_fp8_f32(v[4 * j][c] * cs, v[4 * j + 1][c] * cs, (int)x, false); x = (unsigned)__builtin_amdgcn_cvt_pk_fp8_f32(v[4 * j + 2][c] * cs, v[4 * j + 3][c] * cs, (int)x, true); w[j] = x; }
        *(LAS u32x4*)(tile + (c * 64 + lane) * CT_PITCH + 16 * wave) = (u32x4){w[0], w[1], w[2], w[3]}; }
    __syncthreads();
#pragma unroll
    for (int j = 0; j < 4; ++j) { const int q = tid + 512 * j, g = q >> 3, nr = (g & 63) * 4 + (g >> 6), pc = q & 7, ncol = 256 * t.nb + nr;
        if (ncol < t.N) { const u32x4 w = *(const LAS u32x4*)(tile + g * CT_PITCH + 16 * pc); *(u32x4*)(t.WT + (size_t)map_col_rt(t.map, ncol) * t.K + 128 * t.kb + 16 * pc) = w; } }
    __syncthreads();
}
template <class NextFn, class DescFn>
__device__ __forceinline__ void ctile_run(const Frame& F, const int total, NextFn next, DescFn desc) {
    LAS unsigned char* tile = F.lds;
    const int fa = next();
    if (fa >= total) return;
    f32x4 A[16], B[16], C[16];
    CTile ta = desc(fa), tb = ta, tc = ta; ctile_load(ta, F.wave, F.lane, A);
    const int fb = next(); bool hb = fb < total, hc, ha;
    if (hb) { tb = desc(fb); ctile_load(tb, F.wave, F.lane, B); }
    for (;;) {
        { const int f = next(); hc = hb && f < total; if (hc) { tc = desc(f); ctile_load(tc, F.wave, F.lane, C); } }
        ctile_store(ta, A, tile, F.tid, F.wave, F.lane);
        if (!hb) break;
        { const int f = next(); ha = hc && f < total; if (ha) { ta = desc(f); ctile_load(ta, F.wave, F.lane, A); } }
        ctile_store(tb, B, tile, F.tid, F.wave, F.lane);
        if (!hc) break;
        { const int f = next(); hb = ha && f < total; if (hb) { tb = desc(f); ctile_load(tb, F.wave, F.lane, B); } }
        ctile_store(tc, C, tile, F.tid, F.wave, F.lane);
        if (!ha) break;
    }
}
__device__ __forceinline__ int conv_next(const Frame& F, unsigned* counter, int& ch, int& sub) {
    if (++sub < CT_CHUNK && ch >= 0) return ch * CT_CHUNK + sub;
    volatile LAS unsigned* MW = (volatile LAS unsigned*)(F.lds + MISC_OFF) + 16;
    if (F.tid == 0) MW[0] = __hip_atomic_fetch_add(counter, 1u, __ATOMIC_RELAXED, __HIP_MEMORY_SCOPE_AGENT);
    __syncthreads();
    ch = __builtin_amdgcn_readfirstlane((int)MW[0]); sub = 0;
    __syncthreads();
    return ch * CT_CHUNK;
}
__device__ __forceinline__ void conv_pull(const Frame& F, const ConvSrc& c, unsigned* counter) {
    if (F.bid == 0) {
        for (int f = F.wave; f < 32; f += 8) { ConvDesc d; d.mi = f / 8; d.item = f % 8; d.W = c.cw2 + (size_t)d.mi * 256 * 64; d.K = 256; d.N = 64; d.job = 7;
            TileRegs r; tile_load(d, F.lane, r); tile_store<0, false>(r, 256, 64, (bf16*)(c.ws + WS_CMP_W2) + (size_t)d.mi * 256 * 256, nullptr, d.item, F.lane); } }
    int ch = -1, sub = CT_CHUNK;
    ctile_run(F, CT_TOTAL, [&]() { return conv_next(F, counter, ch, sub); }, [&](int f) { return ctile_desc(c, f); });
}
__device__ __forceinline__ void row_load(const float* p, int lane, f32x4 (&v)[8]) {
#pragma unroll
    for (int j = 0; j < 8; ++j) v[j] = *(const f32x4*)(p + 4 * lane + 256 * j);
}
__device__ __forceinline__ void row_load_bf16(const bf16* p, int lane, f32x4 (&v)[8]) {
#pragma unroll
    for (int j = 0; j < 8; ++j) v[j] = ld4_bf16(p + 4 * lane + 256 * j);
}
__device__ __forceinline__ void row_ln(f32x4 (&v)[8], const float* g, const float* b, int lane) {
    float s = 0.f;
#pragma unroll
    for (int j = 0; j < 8; ++j) s += (v[j][0] + v[j][1]) + (v[j][2] + v[j][3]);
    const float mean = wave_sum(s) * (1.f / D); float s2 = 0.f;
#pragma unroll
    for (int j = 0; j < 8; ++j) { v[j] = v[j] - mean; s2 += (v[j][0] * v[j][0] + v[j][1] * v[j][1]) + (v[j][2] * v[j][2] + v[j][3] * v[j][3]); }
    const float rstd = 1.0f / sqrtf(wave_sum(s2) * (1.f / D) + LN_EPS);
#pragma unroll
    for (int j = 0; j < 8; ++j) { const f32x4 gg = *(const f32x4*)(g + 4 * lane + 256 * j), bb = *(const f32x4*)(b + 4 * lane + 256 * j); v[j] = v[j] * rstd * gg + bb; }
}
__device__ __forceinline__ f32x2 row_ln_stats(f32x4 (&v)[8], const float* g, const float* b, int lane) {
    float s = 0.f;
#pragma unroll
    for (int j = 0; j < 8; ++j) s += (v[j][0] + v[j][1]) + (v[j][2] + v[j][3]);
    const float mean = wave_sum(s) * (1.f / D); float s2 = 0.f;
#pragma unroll
    for (int j = 0; j < 8; ++j) { v[j] = v[j] - mean; s2 += (v[j][0] * v[j][0] + v[j][1] * v[j][1]) + (v[j][2] * v[j][2] + v[j][3] * v[j][3]); }
    const float rstd = 1.0f / sqrtf(wave_sum(s2) * (1.f / D) + LN_EPS);
#pragma unroll
    for (int j = 0; j < 8; ++j) { const f32x4 gg = *(const f32x4*)(g + 4 * lane + 256 * j), bb = *(const f32x4*)(b + 4 * lane + 256 * j); v[j] = v[j] * rstd * gg + bb; }
    f32x2 r; r[0] = mean; r[1] = rstd; return r;
}
__device__ __forceinline__ void row_store_bf16(bf16* pb, int lane, const f32x4 (&v)[8]) {
#pragma unroll
    for (int j = 0; j < 8; ++j) { u32x2 w; w.x = pk2(v[j][0], v[j][1]); w.y = pk2(v[j][2], v[j][3]); *(u32x2*)(pb + 4 * lane + 256 * j) = w; }
}
__device__ __forceinline__ void row_store_fp8(unsigned char* p8, int lane, const f32x4 (&v)[8]) {
#pragma unroll
    for (int j = 0; j < 8; ++j) *(unsigned*)(p8 + 4 * lane + 256 * j) = pk4_fp8(v[j]);
}
__device__ __forceinline__ void row_store(float* pf, bf16* pb, int lane, const f32x4 (&v)[8]) {
#pragma unroll
    for (int j = 0; j < 8; ++j) { *(f32x4*)(pf + 4 * lane + 256 * j) = v[j]; u32x2 w; w.x = pk2(v[j][0], v[j][1]); w.y = pk2(v[j][2], v[j][3]); *(u32x2*)(pb + 4 * lane + 256 * j) = w; }
}

__device__ __forceinline__ void row_store_bf16_f8(bf16* pb, unsigned char* p8, int lane, const f32x4 (&v)[8]) {
#pragma unroll
    for (int j = 0; j < 8; ++j) { st4_bf16(pb + 4 * lane + 256 * j, v[j]); *(unsigned*)(p8 + 4 * lane + 256 * j) = pk4_fp8(v[j]); }
}
__device__ __forceinline__ void row_store_f8(float* pf, unsigned char* p8, int lane, const f32x4 (&v)[8]) {
#pragma unroll
    for (int j = 0; j < 8; ++j) { *(f32x4*)(pf + 4 * lane + 256 * j) = v[j]; *(unsigned*)(p8 + 4 * lane + 256 * j) = pk4_fp8(v[j]); }
}
struct GlaCtx { int b, h, n, row0; };
__device__ __forceinline__ void gla_decay(const Frame& F, const GlaCtx& c, const float* GA, const float* wa2, const float* ba, float (&bcum)[16], float& blast) {
    LAS float* AL = (LAS float*)(F.lds + 0); LAS float* WA = (LAS float*)(F.lds + 4096); LAS float* SEG = (LAS float*)(F.lds + 12288);
    const int tid = F.tid;
    if (tid < 256) *(LAS f32x4*)(AL + tid * 4) = *(const f32x4*)(GA + (size_t)c.row0 * 16 + tid * 4);
    { const int r = tid >> 5, d4 = (tid & 31) * 4; *(LAS f32x4*)(WA + r * 128 + d4) = *(const f32x4*)(wa2 + r * 512 + c.h * 128 + d4); }
    __syncthreads();
    const int d = tid & 127, tq = tid >> 7;
    float wa[16];
#pragma unroll
    for (int r = 0; r < 16; ++r) wa[r] = WA[r * 128 + d];
    const float bias = ba[c.h * 128 + d];
    float run = 0.f;
#pragma unroll
    for (int i = 0; i < 16; ++i) { const int t = tq * 16 + i; float z = bias;
#pragma unroll
        for (int r = 0; r < 16; ++r) z += AL[t * 16 + r] * wa[r];
        const float ls = fminf(z, 0.f) - __logf(1.0f + __expf(-fabsf(z)));
        run += ls * (1.0f / 16.0f); bcum[i] = run; }
    SEG[tq * 128 + d] = run;
    __syncthreads();
    float off = 0.f, tot = 0.f;
#pragma unroll
    for (int q = 0; q < 4; ++q) { const float s = SEG[q * 128 + d]; tot += s; if (q < tq) off += s; }
#pragma unroll
    for (int i = 0; i < 16; ++i) bcum[i] += off;
    blast = tot;
}
__device__ __forceinline__ bf16x8 tr_frag(const LAS bf16* base, int stride, int row0, int col0, int lane) {
    const LAS bf16* p = base + (row0 + ((lane & 15) >> 2)) * stride + col0 + 4 * (lane & 3);
    const s16x4 a = __builtin_amdgcn_ds_read_tr16_b64_v4i16((LAS s16x4*)p), b = __builtin_amdgcn_ds_read_tr16_b64_v4i16((LAS s16x4*)(p + 4 * stride));
    return (bf16x8){a[0], a[1], a[2], a[3], b[0], b[1], b[2], b[3]};
}
__device__ __forceinline__ void gla_stage_vs(const Frame& F, const GlaCtx& c, const bf16* GV, LAS bf16* VS) {
#pragma unroll
    for (int k = 0; k < 4; ++k) { const int ch = F.tid + 512 * k, s = ch >> 5, e8 = (ch & 31) * 8;
        *(LAS u32x4*)(VS + s * 264 + e8) = *(const u32x4*)(GV + (size_t)(c.row0 + s) * 1024 + c.h * 256 + e8); }
}
__device__ __forceinline__ void gla_stage_vt(const Frame& F, const GlaCtx& c, const bf16* GV, LAS bf16* VT) {
#pragma unroll
    for (int k = 0; k < 4; ++k) { const int ch = F.tid + 512 * k, s = ch >> 5, e8 = (ch & 31) * 8;
        const u32x4 w = *(const u32x4*)(GV + (size_t)(c.row0 + s) * 1024 + c.h * 256 + e8);
        const unsigned ww[4] = {w.x, w.y, w.z, w.w};
#pragma unroll
        for (int j = 0; j < 4; ++j) { VT[(e8 + 2 * j) * 72 + s] = (bf16)(ww[j] & 0xffffu); VT[(e8 + 2 * j + 1) * 72 + s] = (bf16)(ww[j] >> 16); } }
}
__device__ __forceinline__ void gla_stage1(const Frame& F, int item, const float* GA, const float* wa2, const float* ba, const bf16* GK, const bf16* GV, bf16* UT, float* DEC) {
    GlaCtx c; c.b = item >> 7; c.h = (item >> 5) & 3; c.n = item & 31; c.row0 = c.b * SEQ + c.n * 64;
    LAS bf16* KH = (LAS bf16*)(F.lds + 14336); LAS bf16* VS = (LAS bf16*)(F.lds + 31744);
    gla_stage_vs(F, c, GV, VS);
    const int d = F.tid & 127, tq = F.tid >> 7;
    bf16 kraw[16];
#pragma unroll
    for (int i = 0; i < 16; ++i) kraw[i] = GK[(size_t)(c.row0 + tq * 16 + i) * 512 + c.h * 128 + d];
    float bcum[16], blast;
    gla_decay(F, c, GA, wa2, ba, bcum, blast);
#pragma unroll
    for (int i = 0; i < 16; ++i) { const int t = tq * 16 + i; KH[t * 136 + d] = (bf16)f2bf(bf2f(kraw[i]) * __expf(blast - bcum[i])); }
    if (tq == 0) DEC[(size_t)item * 128 + d] = __expf(blast);
    __syncthreads();
    const int w = F.wave, l15 = F.lane & 15, q = F.lane >> 4;
    bf16x8 af[2][2];
#pragma unroll
    for (int x = 0; x < 2; ++x)
#pragma unroll
        for (int ks = 0; ks < 2; ++ks) af[x][ks] = tr_frag(VS, 264, 32 * ks + 8 * q, 16 * (2 * w + x), F.lane);
    bf16* ut = UT + (size_t)item * 256 * 128;
#pragma unroll
    for (int dt = 0; dt < 8; ++dt) {
        bf16x8 bfr[2];
#pragma unroll
        for (int ks = 0; ks < 2; ++ks) bfr[ks] = tr_frag(KH, 136, 32 * ks + 8 * q, 16 * dt, F.lane);
#pragma unroll
        for (int x = 0; x < 2; ++x) { f32x4 acc = {0.f, 0.f, 0.f, 0.f};
#pragma unroll
            for (int ks = 0; ks < 2; ++ks) acc = __builtin_amdgcn_mfma_f32_16x16x32_bf16(bfr[ks], af[x][ks], acc, 0, 0, 0);
            u32x2 pw; pw.x = pk2(acc[0], acc[1]); pw.y = pk2(acc[2], acc[3]);
            *(u32x2*)(ut + (size_t)(16 * (2 * w + x) + l15) * 128 + 16 * dt + 4 * q) = pw; }
    }
    __syncthreads();
}
__device__ __forceinline__ void gla_scan(const Frame& F, int first_blk, int nblk, const bf16* UT, const float* DEC, bf16* ST) {
    const long nth = (long)nblk * 512, i0 = (long)(F.bid - first_blk) * 512 + F.tid;
    for (long idx = i0; idx < 32L * 256 * 32; idx += nth) {
        const int bh = (int)(idx >> 13), r = (int)(idx & 8191), e = r >> 5, d = (r & 31) * 4;
        f32x4 S = {0.f, 0.f, 0.f, 0.f};
        static_assert(GLA_NCH == 32, "eight batches of four chunks");
        const size_t item0 = (size_t)bh * 32, p0 = (item0 * 256 + e) * 128 + d;
        const bf16* up = UT + p0; bf16* sp = ST + p0; const float* dp = DEC + item0 * 128 + d;
        u32x2 uw[2][4]; f32x4 dc[2][4];
#pragma unroll
        for (int j = 0; j < 4; ++j) { dc[0][j] = *(const f32x4*)(dp + j * 128); uw[0][j] = *(const u32x2*)(up + (size_t)j * 256 * 128); }
#pragma unroll
        for (int nb = 0; nb < 8; ++nb) {
            if (nb + 1 < 8) {
#pragma unroll
                for (int j = 0; j < 4; ++j) { const int n = (nb + 1) * 4 + j; dc[(nb + 1) & 1][j] = *(const f32x4*)(dp + n * 128); uw[(nb + 1) & 1][j] = *(const u32x2*)(up + (size_t)n * 256 * 128); } }
#pragma unroll
            for (int j = 0; j < 4; ++j) { const int n = nb * 4 + j;
                u32x2 w; w.x = pk2(S[0], S[1]); w.y = pk2(S[2], S[3]); *(u32x2*)(sp + (size_t)n * 256 * 128) = w;
                const u32x2 u2 = uw[nb & 1][j]; const f32x4 uu = {bf2f(u2.x & 0xffffu), bf2f(u2.x >> 16), bf2f(u2.y & 0xffffu), bf2f(u2.y >> 16)}; S = dc[nb & 1][j] * S + uu; }
        }
    }
}
__device__ __forceinline__ void gla_stage3(const Frame& F, int item, const float* GA, const float* wa2, const float* ba, const float* gng, const bf16* GQ, const bf16* GK, const bf16* GV, const bf16* GR, const bf16* ST, bf16* OGLA) {
    GlaCtx c; c.b = item >> 7; c.h = (item >> 5) & 3; c.n = item & 31; c.row0 = c.b * SEQ + c.n * 64;
    LAS bf16* QS = (LAS bf16*)(F.lds + 14336); LAS bf16* KS = (LAS bf16*)(F.lds + 31744); LAS bf16* VS = (LAS bf16*)(F.lds + 49152); LAS bf16* PS = (LAS bf16*)(F.lds + 86016);
    LAS float* OS = (LAS float*)(F.lds + 0);
    gla_stage_vs(F, c, GV, VS);
    const int d = F.tid & 127, tq = F.tid >> 7;
    bf16 qraw[16], kraw[16];
#pragma unroll
    for (int i = 0; i < 16; ++i) { const size_t g = (size_t)(c.row0 + tq * 16 + i) * 512 + c.h * 128 + d; qraw[i] = GQ[g]; kraw[i] = GK[g]; }
    float bcum[16], blast;
    gla_decay(F, c, GA, wa2, ba, bcum, blast);
#pragma unroll
    for (int i = 0; i < 16; ++i) { const int t = tq * 16 + i;
        QS[t * 136 + d] = (bf16)f2bf(bf2f(qraw[i]) * __expf(bcum[i])); KS[t * 136 + d] = (bf16)f2bf(bf2f(kraw[i]) * __expf(-bcum[i])); }
    __syncthreads();
    const int w = F.wave, l15 = F.lane & 15, q = F.lane >> 4;
#pragma unroll
    for (int x = 0; x < 2; ++x) { const int tile = 2 * w + x, tt = tile >> 2, st = tile & 3; f32x4 acc = {0.f, 0.f, 0.f, 0.f};
        if (st <= tt) {
#pragma unroll
            for (int ks = 0; ks < 4; ++ks) { const bf16x8 a = *(const LAS bf16x8*)(QS + (16 * tt + l15) * 136 + 32 * ks + 8 * q), b = *(const LAS bf16x8*)(KS + (16 * st + l15) * 136 + 32 * ks + 8 * q);
                acc = __builtin_amdgcn_mfma_f32_16x16x32_bf16(a, b, acc, 0, 0, 0); } }
#pragma unroll
        for (int j = 0; j < 4; ++j) { const int t = 16 * tt + 4 * q + j, s = 16 * st + l15; PS[t * 72 + s] = (bf16)f2bf(s <= t ? acc[j] : 0.f); } }
    __syncthreads();
    f32x4 o[2][4];
    const bf16* st_item = ST + (size_t)item * 256 * 128;
#pragma unroll
    for (int x = 0; x < 2; ++x) { const int et = 2 * w + x;
        bf16x8 vf[2], sf[4];
#pragma unroll
        for (int ks = 0; ks < 2; ++ks) vf[ks] = tr_frag(VS, 264, 32 * ks + 8 * q, 16 * et, F.lane);
#pragma unroll
        for (int ks = 0; ks < 4; ++ks) sf[ks] = *(const bf16x8*)(st_item + (size_t)(16 * et + l15) * 128 + 32 * ks + 8 * q);
#pragma unroll
        for (int tt = 0; tt < 4; ++tt) { f32x4 acc = {0.f, 0.f, 0.f, 0.f};
#pragma unroll
            for (int ks = 0; ks < 2; ++ks) { const bf16x8 a = *(const LAS bf16x8*)(PS + (16 * tt + l15) * 72 + 32 * ks + 8 * q); acc = __builtin_amdgcn_mfma_f32_16x16x32_bf16(a, vf[ks], acc, 0, 0, 0); }
#pragma unroll
            for (int ks = 0; ks < 4; ++ks) { const bf16x8 a = *(const LAS bf16x8*)(QS + (16 * tt + l15) * 136 + 32 * ks + 8 * q); acc = __builtin_amdgcn_mfma_f32_16x16x32_bf16(a, sf[ks], acc, 0, 0, 0); }
            o[x][tt] = acc; } }
    u32x2 rwv[8];
#pragma unroll
    for (int r = 0; r < 8; ++r) rwv[r] = *(const u32x2*)(GR + (size_t)(c.row0 + 8 * w + r) * 1024 + c.h * 256 + 4 * F.lane);
    const f32x4 gn = *(const f32x4*)(gng + c.h * 256 + 4 * F.lane);
    __syncthreads();
#pragma unroll
    for (int x = 0; x < 2; ++x)
#pragma unroll
        for (int tt = 0; tt < 4; ++tt)
#pragma unroll
            for (int j = 0; j < 4; ++j) OS[(16 * tt + 4 * q + j) * 260 + 16 * (2 * w + x) + l15] = o[x][tt][j];
    __syncthreads();
#pragma unroll
    for (int r = 0; r < 8; ++r) { const int t = 8 * w + r; f32x4 v = *(const LAS f32x4*)(OS + t * 260 + 4 * F.lane);
        const float mean = wave_sum((v[0] + v[1]) + (v[2] + v[3])) * (1.f / 256.f); v = v - mean;
        const float var = wave_sum((v[0] * v[0] + v[1] * v[1]) + (v[2] * v[2] + v[3] * v[3])) * (1.f / 256.f); const float rstd = 1.0f / sqrtf(var + LN_EPS);
        const size_t g = (size_t)(c.row0 + t) * 1024 + c.h * 256 + 4 * F.lane; const u32x2 rw = rwv[r];
        v = v * rstd * gn; v[0] *= bf2f(rw.x & 0xffffu); v[1] *= bf2f(rw.x >> 16); v[2] *= bf2f(rw.y & 0xffffu); v[3] *= bf2f(rw.y >> 16);
        *(unsigned*)((unsigned char*)OGLA + g) = pk4_fp8(v); }
    __syncthreads();
}

template <int DH> struct FlashSt { f32x4 o[2][DH / 16]; f32x4 la[2]; float m[2]; };
template <int DH> __device__ __forceinline__ void flash_init(FlashSt<DH>& s) {
#pragma unroll
    for (int rt = 0; rt < 2; ++rt) {
#pragma unroll
        for (int dt = 0; dt < DH / 16; ++dt) s.o[rt][dt] = (f32x4){0.f, 0.f, 0.f, 0.f};
        s.m[rt] = -1e30f; s.la[rt] = (f32x4){0.f, 0.f, 0.f, 0.f}; }
}
template <int DH> __device__ __forceinline__ float flash_l(const FlashSt<DH>& s, int rt) { return s.la[rt][0]; }
template <int DH> struct FlashLds { static constexpr int KSTR = DH + 8, KT = 0, VT = 64 * KSTR * 2, BUFSZ = 2 * VT; };
template <int DH> struct KvRegs { u32x4 k[DH / 64], v[DH / 64]; };
template <int DH> __device__ __forceinline__ void kv_load(const Frame& F, const bf16* kg, int kstr, const bf16* vg, int vstr, KvRegs<DH>& r) {
#pragma unroll
    for (int k = 0; k < DH / 64; ++k) { const int ch = F.tid + 512 * k, key = ch / (DH / 8), c8 = (ch % (DH / 8)) * 8;
        r.k[k] = *(const u32x4*)(kg + (size_t)key * kstr + c8); r.v[k] = *(const u32x4*)(vg + (size_t)key * vstr + c8); }
}
template <int DH> __device__ __forceinline__ void kv_store(const Frame& F, LAS unsigned char* buf, const KvRegs<DH>& r, bool zero_last) {
    typedef FlashLds<DH> L; LAS bf16* KT = (LAS bf16*)(buf + L::KT); LAS bf16* VTt = (LAS bf16*)(buf + L::VT);
#pragma unroll
    for (int k = 0; k < DH / 64; ++k) { const int ch = F.tid + 512 * k, key = ch / (DH / 8), c8 = (ch % (DH / 8)) * 8;
        u32x4 kw = r.k[k], vw = r.v[k];
        if (zero_last && key == 63) { kw = (u32x4){0u, 0u, 0u, 0u}; vw = kw; }
        *(LAS u32x4*)(KT + key * L::KSTR + c8) = kw;
        *(LAS u32x4*)(VTt + key * L::KSTR + c8) = vw; }
}
template <int DH> __device__ __forceinline__ void flash_scores(const Frame& F, LAS unsigned char* buf, const bf16x8 (&qf)[2][DH / 32], f32x4 (&s)[2][4]) {
    typedef FlashLds<DH> L; const LAS bf16* KT = (const LAS bf16*)(buf + L::KT); const int l15 = F.lane & 15, q = F.lane >> 4;
#pragma unroll
    for (int ct = 0; ct < 4; ++ct) {
        bf16x8 kf[DH / 32];
#pragma unroll
        for (int ks = 0; ks < DH / 32; ++ks) kf[ks] = *(const LAS bf16x8*)(KT + (16 * ct + l15) * L::KSTR + 32 * ks + 8 * q);
#pragma unroll
        for (int rt = 0; rt < 2; ++rt) { f32x4 acc = {0.f, 0.f, 0.f, 0.f};
#pragma unroll
            for (int ks = 0; ks < DH / 32; ++ks) acc = __builtin_amdgcn_mfma_f32_16x16x32_bf16(kf[ks], qf[rt][ks], acc, 0, 0, 0);
            s[rt][ct] = acc; } }
}
struct TileMod { float base[2], step, lo[2], hi[2]; bool need_mask; };
template <int DH, bool PLAIN> __device__ __forceinline__ void flash_tile(const Frame& F, LAS unsigned char* buf, const bf16x8 (&qf)[2][DH / 32], FlashSt<DH>& st, const TileMod& tm, const float (&c0)[16]) {
    typedef FlashLds<DH> L; const LAS bf16* VTt = (const LAS bf16*)(buf + L::VT);
    const int l15 = F.lane & 15, q = F.lane >> 4;
    f32x4 s[2][4];
    flash_scores<DH>(F, buf, qf, s);
    __builtin_amdgcn_sched_barrier(0);
    bf16x8 pf[2][2];
    const float kq = (float)(4 * q);
    bool dead[2] = {false, false};
#pragma unroll
    for (int rt = 0; rt < 2; ++rt) {
        if (!PLAIN) { dead[rt] = __all(tm.base[rt] < -1.0e37f); }
        if (dead[rt]) { pf[rt][0] = (bf16x8){0, 0, 0, 0, 0, 0, 0, 0}; pf[rt][1] = pf[rt][0]; continue; }
        const float base = PLAIN ? 0.f : tm.base[rt];
        if (!PLAIN) {
#pragma unroll
            for (int ct = 0; ct < 4; ++ct)
#pragma unroll
                for (int j = 0; j < 4; ++j) s[rt][ct][j] += c0[ct * 4 + j];
            if (tm.need_mask) { const float lo = tm.lo[rt] - kq, hi = tm.hi[rt] - kq;
#pragma unroll
                for (int ct = 0; ct < 4; ++ct)
#pragma unroll
                    for (int j = 0; j < 4; ++j) { const float kk = (float)(16 * ct + j); s[rt][ct][j] = (kk >= lo && kk <= hi) ? s[rt][ct][j] : -3.0e38f; } }
        }
        float mx = -3.0e38f;
#pragma unroll
        for (int ct = 0; ct < 4; ++ct) mx = fmaxf(mx, fmaxf(fmaxf(s[rt][ct][0], s[rt][ct][1]), fmaxf(s[rt][ct][2], s[rt][ct][3])));
        mx = fmaxf(mx + base, -1e30f);
        mx = fmaxf(mx, __shfl_xor(mx, 16)); mx = fmaxf(mx, __shfl_xor(mx, 32));
        const bool grow = mx > st.m[rt] + 8.0f; const float mn = grow ? mx : st.m[rt];
        const float sh = mn - base;
#pragma unroll
        for (int ct = 0; ct < 4; ++ct)
#pragma unroll
            for (int j = 0; j < 4; ++j) s[rt][ct][j] = __builtin_amdgcn_exp2f(s[rt][ct][j] - sh);
        if (__any(grow)) { const float alpha = __builtin_amdgcn_exp2f(st.m[rt] - mn); st.la[rt] = st.la[rt] * alpha;
#pragma unroll
            for (int dt = 0; dt < DH / 16; ++dt) st.o[rt][dt] = st.o[rt][dt] * alpha; }
        st.m[rt] = mn;
#pragma unroll
        for (int ks = 0; ks < 2; ++ks) { u32x4 w; w.x = cvt_pk_bf16(s[rt][2 * ks][0], s[rt][2 * ks][1]); w.y = cvt_pk_bf16(s[rt][2 * ks][2], s[rt][2 * ks][3]);
            w.z = cvt_pk_bf16(s[rt][2 * ks + 1][0], s[rt][2 * ks + 1][1]); w.w = cvt_pk_bf16(s[rt][2 * ks + 1][2], s[rt][2 * ks + 1][3]); pf[rt][ks] = __builtin_bit_cast(bf16x8, w); }
    }
    __builtin_amdgcn_sched_barrier(0);
    { const bf16x8 ones = (bf16x8){0x3f80, 0x3f80, 0x3f80, 0x3f80, 0x3f80, 0x3f80, 0x3f80, 0x3f80};
#pragma unroll
      for (int rt = 0; rt < 2; ++rt) if (!dead[rt])
#pragma unroll
        for (int ks = 0; ks < 2; ++ks) st.la[rt] = __builtin_amdgcn_mfma_f32_16x16x32_bf16(ones, pf[rt][ks], st.la[rt], 0, 0, 0); }
#pragma unroll
    for (int dt = 0; dt < DH / 16; ++dt) {
        bf16x8 vf[2];
#pragma unroll
        for (int ks = 0; ks < 2; ++ks) { const LAS bf16* vp = VTt + (32 * ks + 4 * q + (l15 >> 2)) * L::KSTR + 16 * dt + 4 * (l15 & 3);
            const s16x4 a = __builtin_amdgcn_ds_read_tr16_b64_v4i16((LAS s16x4*)vp), b = __builtin_amdgcn_ds_read_tr16_b64_v4i16((LAS s16x4*)(vp + 16 * L::KSTR));
            vf[ks] = (bf16x8){a[0], a[1], a[2], a[3], b[0], b[1], b[2], b[3]}; }
#pragma unroll
        for (int rt = 0; rt < 2; ++rt) if (!dead[rt])
#pragma unroll
            for (int ks = 0; ks < 2; ++ks) st.o[rt][dt] = __builtin_amdgcn_mfma_f32_16x16x32_bf16(vf[ks], pf[rt][ks], st.o[rt][dt], 0, 0, 0);
    }
}
template <int DH, bool PLAIN, class MaskGen> __device__ __forceinline__ void flash_run(const Frame& F, LAS unsigned char* base, const bf16x8 (&qf)[2][DH / 32], FlashSt<DH>& st, unsigned bits,
                                                                          const bf16* kb, const bf16* vb, size_t tstride, int kstr, bool zero_tile1, const MaskGen& mg, int& buf, const KvRegs<DH> pre = KvRegs<DH>{}, const bool has_pre = false) {
    typedef FlashLds<DH> L;
    if (bits == 0u) return;
    int jb = __builtin_ctz(bits); bits &= bits - 1u;
    KvRegs<DH> r; if (has_pre) r = pre; else kv_load<DH>(F, kb + jb * tstride, kstr, vb + jb * tstride, kstr, r);
    float c0[16];
    { const float step = PLAIN ? 0.f : mg(jb).step; const float kq = (float)(4 * (F.lane >> 4));
#pragma unroll
      for (int i = 0; i < 16; ++i) c0[i] = step * ((float)(16 * (i >> 2) + (i & 3)) + kq); }
    for (;;) {
        kv_store<DH>(F, base + buf * L::BUFSZ, r, zero_tile1 && jb == 1);
        __syncthreads();
        const int jn = bits ? __builtin_ctz(bits) : -1;
        if (jn >= 0) { bits &= bits - 1u; kv_load<DH>(F, kb + jn * tstride, kstr, vb + jn * tstride, kstr, r); }
        flash_tile<DH, PLAIN>(F, base + buf * L::BUFSZ, qf, st, mg(jb), c0);
        buf ^= 1;
        if (jn < 0) break;
        jb = jn;
    }
}

struct NsaRowInfo { int t[2]; float slope2; };
struct GenNsa { NsaRowInfo ri; int mode, qb; unsigned selm[2];
    __device__ __forceinline__ TileMod operator()(int jb) const { TileMod m; const int k0 = 64 * jb;
        if (mode == 0) { m.step = 16.0f * ri.slope2; m.need_mask = true;
#pragma unroll
            for (int rt = 0; rt < 2; ++rt) { const float tt = (float)(ri.t[rt] - 16 * k0); m.base[rt] = -ri.slope2 * (tt - 15.5f); m.lo[rt] = -1.0f; m.hi[rt] = floorf((tt - 31.0f) * 0.0625f); } }
        else { m.step = ri.slope2; m.need_mask = (jb == qb) || (mode == 2 && jb + 8 <= qb);
#pragma unroll
            for (int rt = 0; rt < 2; ++rt) { const float tt = (float)(ri.t[rt] - k0); const bool rowok = mode == 2 || ((selm[rt] >> jb) & 1u);
                m.base[rt] = rowok ? -ri.slope2 * tt : -3.0e38f; m.hi[rt] = tt; m.lo[rt] = mode == 2 ? tt - 511.0f : -1.0f; } }
        return m; } };
struct GenNone { __device__ __forceinline__ TileMod operator()(int) const { TileMod m; m.base[0] = 0.f; m.base[1] = 0.f; m.step = 0.f; m.lo[0] = 0.f; m.lo[1] = 0.f; m.hi[0] = 0.f; m.hi[1] = 0.f; m.need_mask = false; return m; } };

__device__ __forceinline__ void nsa_unit(const Frame& F0, int unit, const bf16* NQ, const bf16* KCC, const bf16* KV4, const float* NG, bf16* ONSA) {
    Frame F = F0; { int t_ = F0.tid; asm volatile("" : "+v"(t_)); F.tid = t_; F.lane = t_ & 63; }
    const int b = unit >> 7, g = (unit >> 5) & 3, qb = unit & 31;
    LAS unsigned char* fb = F.lds;
    LAS float* PN = (LAS float*)(F.lds + 18432);
    LAS unsigned* SC = (LAS unsigned*)(F.lds + 52224);
    LAS unsigned* UM = (LAS unsigned*)(F.lds + 52480);
    LAS float* IMP = (LAS float*)(F.lds + 52736);
    LAS float* OT = (LAS float*)(F.lds + 61440) + F.wave * 2048 + F.lane;
    const int w = F.wave, l15 = F.lane & 15, q = F.lane >> 4;
    const size_t tok0 = (size_t)b * SEQ + 64 * qb;
    bf16x8 qf[2][2]; NsaRowInfo ri; size_t tokr[2];
    const int hh = l15 & 3;
#pragma unroll
    for (int rt = 0; rt < 2; ++rt) { const int tl = 8 * w + 4 * rt + (l15 >> 2); tokr[rt] = tok0 + tl; ri.t[rt] = 64 * qb + tl;
#pragma unroll
        for (int ks = 0; ks < 2; ++ks) qf[rt][ks] = *(const bf16x8*)(NQ + tokr[rt] * 1024 + g * 256 + hh * 64 + 32 * ks + 8 * q); }
    ri.slope2 = exp2f(-0.5f * (float)(4 * g + hh + 1)) * 1.4426950408889634f;
    float gts[2][3];
#pragma unroll
    for (int rt = 0; rt < 2; ++rt)
#pragma unroll
        for (int br = 0; br < 3; ++br) gts[rt][br] = NG[tokr[rt] * 48 + (g * 4 + hh) * 3 + br];
    if (F.tid == 0) UM[0] = 0u;
    FlashSt<64> st; int buf = 0;
    const bf16* kc = KCC + (size_t)(b * 4 + g) * 128 * 64; const bf16* vc = KCC + (size_t)4096 * 64 + (size_t)(b * 4 + g) * 128 * 64;
    const int ncmp_tiles = (4 * qb + 2 >= 64) ? 2 : 1;
    unsigned um = 0u; GenNsa gen; gen.ri = ri; gen.qb = qb; gen.selm[0] = 0u; gen.selm[1] = 0u;
#define NSA_ACCUM(br) do { _Pragma("unroll") for (int rt = 0; rt < 2; ++rt) { const float gt = gts[rt][(br)]; const float lr_ = flash_l<64>(st, rt); const float sc = lr_ > 0.f ? gt / lr_ : 0.f; \
        _Pragma("unroll") for (int dt = 0; dt < 4; ++dt) _Pragma("unroll") for (int j = 0; j < 4; ++j) { LAS float* o = OT + ((rt * 4 + dt) * 4 + j) * 64; const float v = st.o[rt][dt][j] * sc; *o = (br) == 0 ? v : *o + v; } } } while (0)
    gen.mode = 0;
    flash_init<64>(st);
    flash_run<64, false>(F, fb, qf, st, (1u << ncmp_tiles) - 1u, kc, vc, (size_t)64 * 64, 64, true, gen, buf);
    KvRegs<64> rp[2];
    kv_load<64>(F, kc, 64, vc, 64, rp[0]); if (ncmp_tiles == 2) kv_load<64>(F, kc + 64 * 64, 64, vc + 64 * 64, 64, rp[1]); else rp[1] = rp[0];
    NSA_ACCUM(0);
    __builtin_amdgcn_sched_barrier(0);
    __syncthreads();
#pragma unroll
    for (int ti = 0; ti < 2; ++ti) { if (ti < ncmp_tiles) {
        kv_store<64>(F, fb, rp[ti], ti == 1);
        __syncthreads();
        f32x4 s[2][4];
        flash_scores<64>(F, fb, qf, s);
        const TileMod tm = gen(ti); const float kq = (float)(4 * q);
#pragma unroll
        for (int rt = 0; rt < 2; ++rt) { const float lr_ = flash_l<64>(st, rt); const float inv = lr_ > 0.f ? 1.0f / lr_ : 0.f; const float b0 = tm.base[rt] + tm.step * kq - st.m[rt], hi = tm.hi[rt] - kq;
#pragma unroll
            for (int ct = 0; ct < 4; ++ct)
#pragma unroll
                for (int j = 0; j < 4; ++j) { const float kk = (float)(16 * ct + j); const float x = (s[rt][ct][j] + b0) + tm.step * kk; float p = kk <= hi ? __builtin_amdgcn_exp2f(x) * inv : 0.f;
                    p += __shfl_xor(p, 1); p += __shfl_xor(p, 2);
                    if (hh == 0) PN[(8 * w + 4 * rt + (l15 >> 2)) * 132 + 64 * ti + 16 * ct + 4 * q + j] = p; } }
        __syncthreads();
    } }
    { const int tl = F.tid >> 3, jj = F.tid & 7; float cv[4];
#pragma unroll
        for (int k = 0; k < 4; ++k) { const int j = jj + 8 * k; float a = -1.0f;
            if (j >= 1 && j <= qb - 2) { const int na = 4 * j - 1, nb = 4 * j + 3; a = 0.f; for (int n = na; n <= nb; ++n) a += PN[tl * 132 + n]; }
            cv[k] = a; }
        unsigned mask;
        if (qb + 1 <= 8) mask = (1u << (qb + 1)) - 1u;
        else { mask = 1u | (1u << qb) | (1u << (qb - 1));
#pragma unroll 1
            for (int it = 0; it < 5; ++it) { float bv = -1.0f; int bj = 64;
#pragma unroll
                for (int k = 0; k < 4; ++k) if (cv[k] > bv) { bv = cv[k]; bj = jj + 8 * k; }
#pragma unroll
                for (int off = 1; off < 8; off <<= 1) { const float ov = __shfl_xor(bv, off); const int oj = __shfl_xor(bj, off); if (ov > bv || (ov == bv && oj < bj)) { bv = ov; bj = oj; } }
                if (bv >= 0.f) { mask |= 1u << bj;
#pragma unroll
                    for (int k = 0; k < 4; ++k) if (jj + 8 * k == bj) cv[k] = -1.0f; } } }
        if (jj == 0) { SC[tl] = mask; atomicOr((unsigned*)UM, mask); } }
    __syncthreads();
    um = UM[0]; gen.selm[0] = SC[8 * w + (l15 >> 2)]; gen.selm[1] = SC[8 * w + 4 + (l15 >> 2)];
    buf = 0;
    __builtin_amdgcn_sched_barrier(0);
    const int j0 = qb - 8 < 0 ? 0 : qb - 8; const unsigned wbits = (qb == 31 ? 0xffffffffu : ((1u << (qb + 1)) - 1u)) & ~((1u << j0) - 1u);
    const bf16* ks_ = KV4 + ((size_t)b * SEQ) * 256 + g * 64;
    gen.mode = 1;
    flash_init<64>(st);
    flash_run<64, false>(F, fb, qf, st, um, ks_, ks_ + (size_t)M * 256, (size_t)64 * 256, 256, false, gen, buf);
    KvRegs<64> rw; kv_load<64>(F, ks_ + (size_t)2 * M * 256 + (size_t)j0 * 64 * 256, 256, ks_ + (size_t)3 * M * 256 + (size_t)j0 * 64 * 256, 256, rw);
    NSA_ACCUM(1);
    __builtin_amdgcn_sched_barrier(0);
    gen.mode = 2;
    flash_init<64>(st);
    flash_run<64, false>(F, fb, qf, st, wbits, ks_ + (size_t)2 * M * 256, ks_ + (size_t)3 * M * 256, (size_t)64 * 256, 256, false, gen, buf, rw, true);
    __builtin_amdgcn_sched_barrier(0);
#undef NSA_ACCUM
#pragma unroll
    for (int rt = 0; rt < 2; ++rt) { const float gt = gts[rt][2]; const float lr_ = flash_l<64>(st, rt); const float sc = lr_ > 0.f ? gt / lr_ : 0.f;
        unsigned char* p = (unsigned char*)ONSA + tokr[rt] * 1024 + g * 256 + hh * 64 + 4 * q;
#pragma unroll
        for (int dt = 0; dt < 4; ++dt) { float v[4];
#pragma unroll
            for (int j = 0; j < 4; ++j) v[j] = OT[((rt * 4 + dt) * 4 + j) * 64] + st.o[rt][dt][j] * sc;
            *(unsigned*)(p + 16 * dt) = pk4_fp8((f32x4){v[0], v[1], v[2], v[3]}); } }
    __syncthreads();
}

__device__ __forceinline__ void xattn_unit(const Frame& F, int unit, const bf16* XQ, const bf16* XKV, unsigned char* OXA) {
    const int b = unit >> 5, hd = (unit >> 3) & 3, qk = unit & 7;
    const int w = F.wave, l15 = F.lane & 15, q = F.lane >> 4;
    const size_t row0 = (size_t)b * SEQ + 256 * qk + 32 * w;
    bf16x8 qf[2][4];
#pragma unroll
    for (int rt = 0; rt < 2; ++rt)
#pragma unroll
        for (int ks = 0; ks < 4; ++ks) qf[rt][ks] = *(const bf16x8*)(XQ + (row0 + 16 * rt + l15) * 512 + hd * 128 + 32 * ks + 8 * q);
    FlashSt<128> st; flash_init<128>(st);
    GenNone gn; int buf = 0;
    const bf16* kg = XKV + ((size_t)b * 256) * 1024 + hd * 128;
    flash_run<128, true>(F, F.lds, qf, st, 0xFu, kg, kg + 512, (size_t)64 * 1024, 1024, false, gn, buf);
#pragma unroll
    for (int rt = 0; rt < 2; ++rt) { const float sc = 1.0f / flash_l<128>(st, rt); unsigned char* p = OXA + (row0 + 16 * rt + l15) * 512 + hd * 128 + 4 * q;
#pragma unroll
        for (int dt = 0; dt < 8; ++dt) *(unsigned*)(p + 16 * dt) = pk4_fp8(st.o[rt][dt] * sc); }
    __syncthreads();
}

__device__ __forceinline__ unsigned long long ptab_get(const Frame& F, int i) {
    const LAS unsigned* p = (const LAS unsigned*)(F.lds + PTAB_OFF) + 2 * i;
    const unsigned lo = __builtin_amdgcn_readfirstlane(p[0]), hi = __builtin_amdgcn_readfirstlane(p[1]);
    return ((unsigned long long)hi << 32) | lo;
}
#define INP(i) ((const float*)(GAS const float*)ptab_get(P, (i)))
#define WSB() ((unsigned char*)ptab_get(F, 26))
#define WSP(T, off) ((T*)(GAS T*)(wsb + (off)))
#define PHASE_FRAME() Frame P = F; { int t_ = F.wave * 64 + (int)__builtin_amdgcn_mbcnt_hi(~0u, __builtin_amdgcn_mbcnt_lo(~0u, 0u)); asm volatile("" : "+v"(t_)); P.tid = t_; P.lane = t_ & 63; P.wave = __builtin_amdgcn_readfirstlane(t_ >> 6); } GAS unsigned char* wsb = (GAS unsigned char*)ptab_get(P, 26)

#ifndef LPMASK
#define LPMASK 0xFFFFFFFFu
#endif
#ifndef GPMASK
#define GPMASK 3u
#endif
#define IN(k) (lo <= (k) && (k) < hi)
#define HAVEL(p) (((LPMASK) >> (p)) & 1u)
#ifndef REPMASK
#define REPMASK 0u
#endif
#define NREP(p) (1 + (int)(((REPMASK) >> (p)) & 1u))
#define HAVEG(p) (((GPMASK) >> (p)) & 1u)
#define SEAM(k) do { if (IN(k) && IN((k) + 1)) xcd_barrier(bar); } while (0)

template <int L> __device__ __forceinline__ void layer_body(const Frame& F, const XcdBarrier& bar, const int lo, const int hi) {
    constexpr int l = L;
    const int gw = F.bid * 8 + F.wave, NGW = F.G * 8;
        const int pb = PH_L0 + l * PH_PER_LAYER;
        if (HAVEL(LP_INPROJ) && IN(pb + LP_INPROJ)) for (int rep_ = 0; rep_ < NREP(LP_INPROJ); ++rep_) {
            PHASE_FRAME();
            pg8::Gemm g{(const bf16*)wsb, (const bf16*)wsb, D / 2, D / 2, D / 2};
            constexpr int NCV = (l == 0) ? CONV_BLOCKS : 0;
            pg8::InProjOrder S; S.d.init(M, D_INP, 1, P.G - NCV, P.bid - NCV, D / 2, D / 2, 0, 0); S.extra = (l == 0) ? 64 : 0;
            S.a0 = (unsigned)WS_XB8; S.b0 = (unsigned)(WS_W_IN + (size_t)l * D_INP * D); S.a1 = (unsigned)WS_MEMB; S.b1 = (unsigned)WS_XA_WKV;
            pg8::EpiInProj E{wsb, (const LAS unsigned*)(P.lds + IPTAB_OFF)};
            if (P.bid >= NCV) pg8::gemm_phase<pg8::EpiInProj, pg8::InProjOrder, true>(P.lds, P.tid, g, S, E);
            if (l == 0) { ConvSrc cs{INP(I_WIN), INP(I_WBG), INP(I_WBN), INP(I_WOUT), INP(I_XWQ), INP(I_XWO), INP(I_CW1), INP(I_CW2), INP(I_MW1), INP(I_MW2), wsb};
                conv_pull(P, cs, WSP(unsigned, WS_CTL) + CW_CONVQ); }
        }
        SEAM(pb + LP_INPROJ);
        const int ncmp = F.G >= 64 ? 32 : 0;
        if (HAVEL(LP_A) && IN(pb + LP_A)) for (int rep_ = 0; rep_ < NREP(LP_A); ++rep_) {
            PHASE_FRAME();
            if (P.bid < ncmp || ncmp == 0) {
                pg8::Gemm g{WSP(bf16, WS_KC), (const bf16*)(WSP(unsigned char, WS_CMP_W1) + (size_t)l * 2 * 256 * 2048), 512, 1024, 1024}; pg8::DenseOrder S; S.init(4096, 256, 2, ncmp ? ncmp : P.G, P.bid, 512, 1024, (unsigned)M * 256u, 256u * 2048u);
                pg8::EpiCmp1 E{WSP(bf16, WS_H1), WSP(float, WS_CMP_B1) + l * 512};
                pg8::gemm_phase<pg8::EpiCmp1, pg8::DenseOrder, true>(P.lds, P.tid, g, S, E);
            }
            if (P.bid >= ncmp) { const float* wa2 = INP(I_WA2) + (size_t)l * 16 * 512; const float* ba = INP(I_BA) + l * 512;
                for (int it = P.bid - ncmp; it < 1024; it += P.G - ncmp)
                    gla_stage1(P, it, WSP(float, WS_GA), wa2, ba, WSP(bf16, WS_GK), WSP(bf16, WS_GV), WSP(bf16, WS_UT), WSP(float, WS_DEC)); }
        }
        SEAM(pb + LP_A);
        if (HAVEL(LP_B) && IN(pb + LP_B)) for (int rep_ = 0; rep_ < NREP(LP_B); ++rep_) {
            PHASE_FRAME();
            if (P.bid < ncmp || ncmp == 0) {
                pg8::Gemm g{WSP(bf16, WS_H1), WSP(bf16, WS_CMP_W2) + (size_t)l * 2 * 256 * 256, 256, 256, 256}; pg8::DenseOrder S; S.init(4096, 256, 2, ncmp ? ncmp : P.G, P.bid, 256, 256, 4096u * 256u * 2u, 256u * 256u * 2u);
                pg8::EpiCmp2 E{WSP(bf16, WS_KCC)};
                pg8::gemm_phase<pg8::EpiCmp2, pg8::DenseOrder, true>(P.lds, P.tid, g, S, E);
            }
            if (P.bid >= ncmp) gla_scan(P, ncmp, P.G - ncmp, WSP(bf16, WS_UT), WSP(float, WS_DEC), WSP(bf16, WS_ST));
        }
        SEAM(pb + LP_B);
        if (HAVEL(LP_GLA3) && IN(pb + LP_GLA3)) for (int rep_ = 0; rep_ < NREP(LP_GLA3); ++rep_) {
            PHASE_FRAME();
            const float* wa2 = INP(I_WA2) + (size_t)l * 16 * 512; const float* ba = INP(I_BA) + l * 512; const float* gng = INP(I_GNG) + l * 1024;
            for (int it = P.bid; it < 1024; it += P.G)
                gla_stage3(P, it, WSP(float, WS_GA), wa2, ba, gng, WSP(bf16, WS_GQ), WSP(bf16, WS_GK), WSP(bf16, WS_GV), WSP(bf16, WS_GR), WSP(bf16, WS_ST), WSP(bf16, WS_OGLA));
        }
        if (IN(pb + LP_GLA3) && IN(pb + LP_GLA3 + 1)) __syncthreads();
        if (HAVEL(LP_NSA) && IN(pb + LP_NSA)) for (int rep_ = 0; rep_ < NREP(LP_NSA); ++rep_) {
            PHASE_FRAME();
            const int npair = (512 - P.bid + P.G - 1) / P.G;
            for (int k = 0; k < 2 * npair; ++k) { const int p0 = P.bid + (k >> 1) * P.G;
                const int p = (P.G == 256) ? ((P.bid & 7) * 64 + (k >> 1) * 32 + (P.bid >> 3)) : p0;
                const int bg = p >> 4, x = p & 15;
                nsa_unit(P, bg * 32 + ((k & 1) ? x : 31 - x), WSP(bf16, WS_NQ), WSP(bf16, WS_KCC), WSP(bf16, WS_KV4), WSP(float, WS_NG), WSP(bf16, WS_ONSA)); }
        }
        SEAM(pb + LP_NSA);
        if (HAVEL(LP_BG) && IN(pb + LP_BG)) for (int rep_ = 0; rep_ < NREP(LP_BG); ++rep_) {
            PHASE_FRAME();
            pg8::Gemm g{WSP(bf16, WS_OGLA), (const bf16*)(WSP(unsigned char, WS_W_BG) + (size_t)l * D * 1024), 512, 512, 512}; pg8::DenseOrder S; S.init(M, D, 1, P.G, P.bid, 512, 512, 0, 0);
            pg8::EpiMerge<1> E{WSP(bf16, WS_M1), WSP(bf16, WS_MG), WSP(unsigned char, WS_M8)};
            pg8::gemm_phase<pg8::EpiMerge<1>, pg8::DenseOrder, true>(P.lds, P.tid, g, S, E);
        }
        if (IN(pb + LP_BG) && IN(pb + LP_BG + 1)) { asm volatile("s_waitcnt vmcnt(0)" ::: "memory"); __syncthreads(); }
        if (HAVEL(LP_BN) && IN(pb + LP_BN)) {
            PHASE_FRAME();
            pg8::Gemm g{WSP(bf16, WS_ONSA), (const bf16*)(WSP(unsigned char, WS_W_BN) + (size_t)l * D * 1024), 512, 512, 512}; pg8::DenseOrder S; S.init(M, D, 1, P.G, P.bid, 512, 512, 0, 0);
            pg8::EpiMerge<2> E{WSP(bf16, WS_M1), WSP(bf16, WS_MG), WSP(unsigned char, WS_M8)};
            pg8::gemm_phase<pg8::EpiMerge<2>, pg8::DenseOrder, true>(P.lds, P.tid, g, S, E);
        }
        SEAM(pb + LP_BN);
        if (HAVEL(LP_WOUT) && IN(pb + LP_WOUT)) for (int rep_ = 0; rep_ < NREP(LP_WOUT); ++rep_) {
            PHASE_FRAME();
            pg8::Gemm g{(const bf16*)WSP(unsigned char, WS_M8), (const bf16*)(WSP(unsigned char, WS_W_OUT) + (size_t)l * D * D), D / 2, D / 2, D / 2}; pg8::DenseOrder S; S.init(M, D, 1, P.G, P.bid, D / 2, D / 2, 0, 0);
            if (l == 0) { pg8::EpiResid<true, false> E{(const void*)INP(I_X), WSP(bf16, WS_V)}; pg8::gemm_phase<pg8::EpiResid<true, false>, pg8::DenseOrder, true>(P.lds, P.tid, g, S, E); }
            else { pg8::EpiResid<true, true> E{(const void*)WSP(const bf16, WS_XC), WSP(bf16, WS_V)}; pg8::gemm_phase<pg8::EpiResid<true, true>, pg8::DenseOrder, true>(P.lds, P.tid, g, S, E); }
        }
        SEAM(pb + LP_WOUT);
        if (HAVEL(LP_LN1) && IN(pb + LP_LN1)) for (int rep_ = 0; rep_ < NREP(LP_LN1); ++rep_) {
            PHASE_FRAME();
            const float* gg = INP(I_LNMG) + l * D; const float* bb = INP(I_LNMB) + l * D; const bf16* V = WSP(const bf16, WS_V); unsigned char* X18 = WSP(unsigned char, WS_XB); f32x2* ST1 = WSP(f32x2, WS_ST1);
            for (int m = gw; m < M; m += 2 * NGW) { const int m2 = m + NGW; f32x4 v[8], w[8]; row_load_bf16(V + (size_t)m * D, P.lane, v); if (m2 < M) row_load_bf16(V + (size_t)m2 * D, P.lane, w);
                { const f32x2 st = row_ln_stats(v, gg, bb, P.lane); row_store_fp8(X18 + (size_t)m * D, P.lane, v); if (P.lane == 0) ST1[m] = st; }
                if (m2 < M) { const f32x2 st = row_ln_stats(w, gg, bb, P.lane); row_store_fp8(X18 + (size_t)m2 * D, P.lane, w); if (P.lane == 0) ST1[m2] = st; } }
        }
        SEAM(pb + LP_LN1);
        if (HAVEL(LP_XQ) && IN(pb + LP_XQ)) for (int rep_ = 0; rep_ < NREP(LP_XQ); ++rep_) {
            PHASE_FRAME();
            pg8::Gemm g{(const bf16*)WSP(unsigned char, WS_XB), (const bf16*)(WSP(unsigned char, WS_XA_WQ) + (size_t)l * 512 * D), D / 2, D / 2, D / 2}; pg8::DenseOrder S; S.init(M, 512, 1, P.G, P.bid, D / 2, D / 2, 0, 0);
            pg8::EpiBf16F8 E{WSP(bf16, WS_XQ), 512};
            pg8::gemm_phase<pg8::EpiBf16F8, pg8::DenseOrder, true>(P.lds, P.tid, g, S, E);
        }
        SEAM(pb + LP_XQ);
        if (HAVEL(LP_XATT) && IN(pb + LP_XATT)) for (int rep_ = 0; rep_ < NREP(LP_XATT); ++rep_) {
            PHASE_FRAME();
            for (int u = P.bid; u < 256; u += P.G) xattn_unit(P, u, WSP(bf16, WS_XQ), WSP(bf16, WS_XKV) + (size_t)l * BATCH * MEM_LEN * 1024, WSP(unsigned char, WS_OXA));
        }
        SEAM(pb + LP_XATT);
        if (HAVEL(LP_WO) && IN(pb + LP_WO)) for (int rep_ = 0; rep_ < NREP(LP_WO); ++rep_) {
            PHASE_FRAME();
            pg8::Gemm g{(const bf16*)WSP(unsigned char, WS_OXA), (const bf16*)(WSP(unsigned char, WS_XA_WO) + (size_t)l * D * 512), 256, 256, 256}; pg8::DenseOrder S; S.init(M, D, 1, P.G, P.bid, 256, 256, 0, 0);
            pg8::EpiResidLN<true> E{WSP(bf16, WS_V), WSP(const f32x2, WS_ST1), INP(I_LNMG) + l * D, INP(I_LNMB) + l * D};
            pg8::gemm_phase<pg8::EpiResidLN<true>, pg8::DenseOrder, true>(P.lds, P.tid, g, S, E);
        }
        const bool pre_rwt = IN(pb + LP_WO) && IN(pb + LP_LN2R);
        if (HAVEL(LP_LN2R) && pre_rwt) { PHASE_FRAME(); LAS float* RWT = (LAS float*)P.lds; const float* rw = INP(I_RW);
            for (int i = P.tid; i < D * N_EXP; i += 512) RWT[i] = rw[(i & (D - 1)) * N_EXP + (i >> 11)]; }
        SEAM(pb + LP_WO);
        if (HAVEL(LP_LN2R) && IN(pb + LP_LN2R)) {
            PHASE_FRAME();
            LAS float* RWT = (LAS float*)P.lds;
            const float* rw = INP(I_RW); const float* rb = INP(I_RB);
            if (!pre_rwt) { for (int i = P.tid; i < D * N_EXP; i += 512) RWT[i] = rw[(i & (D - 1)) * N_EXP + (i >> 11)]; }
            __syncthreads();
            const float* gg = INP(I_LNXG) + l * D; const float* bb = INP(I_LNXB) + l * D;
            const bf16* V = WSP(const bf16, WS_V); unsigned char* X28 = WSP(unsigned char, WS_XB); f32x2* ST2 = WSP(f32x2, WS_ST2); unsigned* TOK = WSP(unsigned, WS_TOK);
            unsigned* counts = WSP(unsigned, WS_CTL) + CW_CNT + l * 16;
            float rbl = 0.f; if (P.lane < 16) rbl = rb[P.lane];
            int cnt = 0;
            int r_e1 = 0, r_e2 = 0, r_p1 = 0, r_p2 = 0, r_m = -1; float r_g1 = 0.f, r_g2 = 0.f;
            int k = 0;
            for (int m = gw; m < M; m += NGW, ++k) {
                float mylg = 0.f;
                { f32x4 v[8]; row_load_bf16(V + (size_t)m * D, P.lane, v); const f32x2 st2 = row_ln_stats(v, gg, bb, P.lane); row_store_fp8(X28 + (size_t)m * D, P.lane, v); if (P.lane == 0) ST2[m] = st2;
                  float p[16];
#pragma unroll
                  for (int e = 0; e < 16; ++e) { float s = 0.f;
#pragma unroll
                    for (int j = 0; j < 8; ++j) { const f32x4 wv = *(const LAS f32x4*)(RWT + e * D + 4 * P.lane + 256 * j); s += (v[j][0] * wv[0] + v[j][1] * wv[1]) + (v[j][2] * wv[2] + v[j][3] * wv[3]); }
                    p[e] = s; __builtin_amdgcn_sched_barrier(0); }
#pragma unroll
                  for (int i = 0; i < 8; ++i) { const bool hi = (P.lane & 32) != 0; const float send = hi ? p[i] : p[i + 8], keep = hi ? p[i + 8] : p[i]; p[i] = keep + __shfl_xor(send, 32); }
#pragma unroll
                  for (int i = 0; i < 4; ++i) { const bool hi = (P.lane & 16) != 0; const float send = hi ? p[i] : p[i + 4], keep = hi ? p[i + 4] : p[i]; p[i] = keep + __shfl_xor(send, 16); }
#pragma unroll
                  for (int i = 0; i < 2; ++i) { const bool hi = (P.lane & 8) != 0; const float send = hi ? p[i] : p[i + 2], keep = hi ? p[i + 2] : p[i]; p[i] = keep + __shfl_xor(send, 8); }
                  { const bool hi = (P.lane & 4) != 0; const float send = hi ? p[0] : p[1], keep = hi ? p[1] : p[0]; p[0] = keep + __shfl_xor(send, 4); }
                  p[0] += __shfl_xor(p[0], 2); p[0] += __shfl_xor(p[0], 1);
                  mylg = p[0]; }
                float lg[16], lb[16];
#pragma unroll
                for (int e = 0; e < 16; ++e) { lg[e] = __shfl(mylg, ((e & 1) << 2) | ((e & 2) << 2) | ((e & 4) << 2) | ((e & 8) << 2)); lb[e] = lg[e] + __shfl(rbl, e); }
                float bs = -3.0e38f; int gb = 0;
#pragma unroll
                for (int gi = 0; gi < 4; ++gi) { float a1 = -3.0e38f, a2 = -3.0e38f;
#pragma unroll
                    for (int e = 0; e < 4; ++e) { const float x = lb[gi * 4 + e]; if (x > a1) { a2 = a1; a1 = x; } else if (x > a2) a2 = x; }
                    const float sc = a1 + a2; if (sc > bs) { bs = sc; gb = gi; } }
                float a1 = -3.0e38f, a2 = -3.0e38f; int i1 = 0, i2 = 0;
#pragma unroll
                for (int gi = 0; gi < 4; ++gi) if (gi == gb) {
#pragma unroll
                    for (int e = 0; e < 4; ++e) { const float x = lb[gi * 4 + e]; if (x > a1) { a2 = a1; i2 = i1; a1 = x; i1 = e; } else if (x > a2) { a2 = x; i2 = e; } } }
                const int e1 = gb * 4 + i1, e2 = gb * 4 + i2;
                float l1 = 0.f, l2 = 0.f;
#pragma unroll
                for (int e = 0; e < 16; ++e) { if (e == e1) l1 = lg[e]; if (e == e2) l2 = lg[e]; }
                const float g1 = 1.0f / (1.0f + __expf(l2 - l1)), g2 = 1.0f - g1;
                const int p1 = __shfl(cnt, e1), p2 = __shfl(cnt, e2);
                if (P.lane == e1 || P.lane == e2) cnt += 1;
                if (P.lane == k) { r_e1 = e1; r_e2 = e2; r_p1 = p1; r_p2 = p2; r_g1 = g1; r_g2 = g2; r_m = m; }
            }
            int base = 0;
            if (P.lane < 16 && cnt > 0) base = (int)__hip_atomic_fetch_add(counts + P.lane, (unsigned)cnt, __ATOMIC_RELAXED, __HIP_MEMORY_SCOPE_AGENT);
            const int b1 = __shfl(base, r_e1), b2 = __shfl(base, r_e2);
            if (r_m >= 0) { unsigned* INV = WSP(unsigned, WS_BUF);
                INV[(size_t)r_e1 * M + (b1 + r_p1)] = (unsigned)r_m; INV[(size_t)r_e2 * M + (b2 + r_p2)] = (unsigned)r_m; }
            if (r_m >= 0) { u32x4 a; a.x = (unsigned)r_e1; a.y = (unsigned)(b1 + r_p1); a.z = (unsigned)r_e2; a.w = (unsigned)(b2 + r_p2);
                u32x4 c; c.x = __builtin_bit_cast(unsigned, r_g1); c.y = __builtin_bit_cast(unsigned, r_g2); c.z = 0u; c.w = 0u;
                *(u32x4*)(TOK + (size_t)r_m * 8) = a; *(u32x4*)(TOK + (size_t)r_m * 8 + 4) = c; }
            __syncthreads();
        }
        SEAM(pb + LP_LN2R);
#define MOE_TABLE() do { if (P.tid == 0) { LAS int* tab = (LAS int*)(P.lds + MOETAB_OFF); LAS int* ps = (LAS int*)(P.lds + PADST_OFF); const unsigned* counts = WSP(unsigned, WS_CTL) + CW_CNT + l * 16; int nb = 0; \
            for (int e = 0; e < N_EXP; ++e) { const int c = (int)__hip_atomic_load(counts + e, __ATOMIC_RELAXED, __HIP_MEMORY_SCOPE_AGENT); const int k = (c + 255) >> 8; ps[e] = nb * 256; ps[16 + e] = c; for (int j = 0; j < k && nb < MOE_MAXBLK; ++j) tab[16 + nb++] = e; } \
            tab[0] = nb; } __syncthreads(); } while (0)
        if (HAVEL(LP_MOE1) && IN(pb + LP_MOE1)) for (int rep_ = 0; rep_ < NREP(LP_MOE1); ++rep_) {
            PHASE_FRAME();
            MOE_TABLE();
            { const LAS int* tab = (const LAS int*)(P.lds + MOETAB_OFF); const LAS int* ps = (const LAS int*)(P.lds + PADST_OFF); LAS unsigned* rt = (LAS unsigned*)(P.lds + ROWTOK_OFF); const unsigned* INV = WSP(const unsigned, WS_BUF);
              const int nblk = tab[0];
              for (int idx = P.tid; idx < 8 * 256; idx += 512) { const int Lu = (idx >> 8) * P.G + P.bid;
                  if (Lu < nblk * 12) { const int blk = Lu / 12, e = tab[16 + blk], c = ps[16 + e]; int pos = blk * 256 - ps[e] + (idx & 255); pos = pos < c ? pos : c - 1;
                      rt[idx] = INV[(size_t)e * M + pos] * (unsigned)D; } }
              __syncthreads(); }
            pg8::Gemm g{WSP(bf16, WS_XB), (const bf16*)(WSP(unsigned char, WS_MOE_W1) + (size_t)l * N_EXP * 2 * D_FF * D), D / 2, D / 2, D / 2};
            pg8::MoeGatherOrder S{(const LAS int*)(P.lds + MOETAB_OFF), 12, P.G, P.bid, D / 2, D / 2, 2u * D_FF * D};
            pg8::EpiMoe1 E{WSP(unsigned char, WS_ACT)};
            pg8::gemm_phase<pg8::EpiMoe1, pg8::MoeGatherOrder, true>(P.lds, P.tid, g, S, E);
        }
        SEAM(pb + LP_MOE1);
        if (HAVEL(LP_MOE2) && IN(pb + LP_MOE2)) for (int rep_ = 0; rep_ < NREP(LP_MOE2); ++rep_) {
            PHASE_FRAME();
            if (!IN(pb + LP_MOE1)) MOE_TABLE();
            pg8::Gemm g{WSP(bf16, WS_ACT), (const bf16*)(WSP(unsigned char, WS_MOE_W2) + (size_t)l * N_EXP * D * D_FF), D_FF / 2, D_FF / 2, D_FF / 2};
            pg8::MoeOrder S{(const LAS int*)(P.lds + MOETAB_OFF), 8, P.G, P.bid, D_FF / 2, D_FF / 2, (unsigned)D * D_FF};
            pg8::EpiMoe2 E{WSP(unsigned char, WS_Y)};
            pg8::gemm_phase<pg8::EpiMoe2, pg8::MoeOrder, true>(P.lds, P.tid, g, S, E);
        }
        SEAM(pb + LP_MOE2);
        if (HAVEL(LP_COMB) && IN(pb + LP_COMB)) {
            PHASE_FRAME();
            const float* gg = INP(I_LNFG) + l * D; const float* bb = INP(I_LNFB) + l * D;
            bf16* XC = WSP(bf16, WS_XC); unsigned char* X8 = WSP(unsigned char, WS_XB8); const unsigned* TOK = WSP(const unsigned, WS_TOK); const unsigned char* Y = WSP(const unsigned char, WS_Y);
            const bf16* Vp = WSP(const bf16, WS_V); const f32x2* ST2 = WSP(const f32x2, WS_ST2); const float* gxa = INP(I_LNXG) + l * D; const float* bxa = INP(I_LNXB) + l * D;
            float* outp = (float*)(GAS float*)ptab_get(P, 25);
            if (!IN(pb + LP_MOE1)) MOE_TABLE();
            const LAS int* ps = (const LAS int*)(P.lds + PADST_OFF);
            for (int m0 = gw; m0 < M; m0 += 2 * NGW) {
                u32x4 c[2], a4[2]; f32x4 v[2][8]; unsigned y1[2][8], y2[2][8];
#pragma unroll
                for (int r = 0; r < 2; ++r) { const int m = m0 + r * NGW; if (m < M) { c[r] = *(const u32x4*)(TOK + (size_t)m * 8 + 4); a4[r] = *(const u32x4*)(TOK + (size_t)m * 8); } else { c[r] = (u32x4){0u, 0u, 0u, 0u}; a4[r] = c[r]; } }
#pragma unroll
                for (int r = 0; r < 2; ++r) { const int m = m0 + r * NGW; if (m < M) { row_load_bf16(Vp + (size_t)m * D, P.lane, v[r]); const size_t s1 = (size_t)(ps[a4[r].x] + (int)a4[r].y), s2 = (size_t)(ps[a4[r].z] + (int)a4[r].w);
#pragma unroll
                    for (int j = 0; j < 8; ++j) { y1[r][j] = *(const unsigned*)(Y + s1 * D + 4 * P.lane + 256 * j); y2[r][j] = *(const unsigned*)(Y + s2 * D + 4 * P.lane + 256 * j); } } }
#pragma unroll
                for (int r = 0; r < 2; ++r) { const int m = m0 + r * NGW; if (m < M) { const float g1 = __builtin_bit_cast(float, c[r].x), g2 = 1.0f - g1; const f32x2 st2 = ST2[m];
#pragma unroll
                    for (int j = 0; j < 8; ++j) { const f32x4 gx = *(const f32x4*)(gxa + 4 * P.lane + 256 * j), bx = *(const f32x4*)(bxa + 4 * P.lane + 256 * j); v[r][j] = (v[r][j] - st2[0]) * st2[1] * gx + bx; }
#pragma unroll
                    for (int j = 0; j < 8; ++j) { const unsigned a = y1[r][j], b = y2[r][j];
                        const f32x2 a01 = __builtin_amdgcn_cvt_pk_f32_fp8((int)a, false), a23 = __builtin_amdgcn_cvt_pk_f32_fp8((int)a, true), b01 = __builtin_amdgcn_cvt_pk_f32_fp8((int)b, false), b23 = __builtin_amdgcn_cvt_pk_f32_fp8((int)b, true);
                        v[r][j][0] = v[r][j][0] * DN_ALPHA + g1 * a01[0] + g2 * b01[0]; v[r][j][1] = v[r][j][1] * DN_ALPHA + g1 * a01[1] + g2 * b01[1];
                        v[r][j][2] = v[r][j][2] * DN_ALPHA + g1 * a23[0] + g2 * b23[0]; v[r][j][3] = v[r][j][3] * DN_ALPHA + g1 * a23[1] + g2 * b23[1]; }
                    row_ln(v[r], gg, bb, P.lane);
                    if (l == DEPTH - 1) {
#pragma unroll
                        for (int j = 0; j < 8; ++j) *(f32x4*)(outp + (size_t)m * D + 4 * P.lane + 256 * j) = v[r][j]; }
                    else row_store_bf16_f8(XC + (size_t)m * D, X8 + (size_t)m * D, P.lane, v[r]); } }
            }
        }
        SEAM(pb + LP_COMB);
    }

__global__ void __launch_bounds__(512, 2) fwd(Args args) {
    extern __shared__ __attribute__((aligned(16))) unsigned char lds_raw[];
    Frame F;
    F.lds = (LAS unsigned char*)lds_raw;
    F.tid = threadIdx.x; F.lane = F.tid & 63; F.wave = __builtin_amdgcn_readfirstlane(F.tid >> 6);
    F.G = gridDim.x; F.bid = blockIdx.x;
    for (int u = F.tid; u < (LDS_BYTES - LDSCTL_OFF) / 4; u += 512) ((LAS unsigned*)(F.lds + LDSCTL_OFF))[u] = 0u;
    __syncthreads();
    { LAS unsigned long long* PT = (LAS unsigned long long*)(F.lds + PTAB_OFF);
      if (F.tid < 25) PT[F.tid] = (unsigned long long)args.in[F.tid];
      if (F.tid == 25) PT[25] = (unsigned long long)args.out;
      if (F.tid == 26) PT[26] = (unsigned long long)args.ws; }
    if (F.tid >= 64 && F.tid < 64 + 38) { const int pn = F.tid - 64; unsigned long long off; unsigned ld, mode = 0u;
        if (pn < 2) { off = WS_GQ + (size_t)pn * 512; ld = 512; }
        else if (pn < 4) { off = WS_GK + (size_t)(pn - 2) * 512; ld = 512; }
        else if (pn < 8) { off = WS_GV + (size_t)(pn - 4) * 512; ld = 1024; }
        else if (pn < 12) { off = WS_GR + (size_t)(pn - 8) * 512; ld = 1024; mode = 1u; }
        else if (pn < 16) { off = WS_NQ + (size_t)(pn - 12) * 512; ld = 1024; }
        else if (pn < 18) { off = WS_KC + (size_t)(pn - 16) * M * 256; ld = 0; mode = 3u; }
        else if (pn < 22) { off = WS_KV4 + (size_t)(pn - 18) * M * 256 * 2; ld = 256; }
        else { off = WS_MG + (size_t)(pn - 22) * 512; ld = 4096; mode = 2u; }
        LAS unsigned* te = (LAS unsigned*)(F.lds + IPTAB_OFF) + 4 * pn; te[0] = (unsigned)off; te[1] = (unsigned)(off >> 32); te[2] = ld; te[3] = mode; }
    if (F.tid >= 128 && F.tid < 128 + 8) { const int e = F.tid - 128, z = e >> 2, pq = e & 3; const unsigned long long off = WS_XKV + (size_t)z * BATCH * MEM_LEN * 1024 * 2 + (size_t)pq * 512;
        LAS unsigned* te = (LAS unsigned*)(F.lds + IPTAB_OFF) + 4 * (39 + e); te[0] = (unsigned)off; te[1] = (unsigned)(off >> 32); te[2] = 1024u; te[3] = 0u; }
    __syncthreads();
    volatile LAS unsigned* MISC = (volatile LAS unsigned*)(F.lds + MISC_OFF);
    const int lo = args.ph_lo, hi = args.ph_hi;
    XcdBarrier bar; bar.bar = (unsigned*)(args.ws + WS_CTL) + CW_BAR; bar.x = 0; bar.st = nullptr;
    if (hi - lo > 1) bar = xcd_barrier_post((unsigned*)(args.ws + WS_CTL) + CW_BAR, MISC + 8);
    const int gw = F.bid * 8 + F.wave, NGW = F.G * 8;

    if (HAVEG(0) && IN(PH_CONV)) {
        PHASE_FRAME();
        { const float* win = INP(I_WIN); const float* xwkv = INP(I_XWKV); int it = P.bid;
          ctile_run(P, 624 + 128, [&]() { const int f = it; it += P.G; return f; },
              [&](int f) { CTile t; if (f < 624) { t.kb = f / 39; t.nb = f % 39; t.W = win; t.WT = WSP(unsigned char, WS_W_IN); t.K = D; t.N = D_IN; t.map = 1; }
                           else { const int r = f - 624, mi = r >> 6; t.kb = (r & 63) >> 2; t.nb = r & 3; t.W = xwkv + (size_t)mi * D * 1024; t.WT = WSP(unsigned char, WS_XA_WKV) + (size_t)mi * 1024 * D; t.K = D; t.N = 1024; t.map = 0; }
                           return t; });
          __syncthreads(); }
        for (int l = 0; l < DEPTH; ++l) zero_bf16(P, (bf16*)(WSP(unsigned char, WS_W_IN) + (size_t)l * D_INP * D + (size_t)D_IN * D), (size_t)(D_INP - D_IN) * D / 2);
        for (int i = 0; i < DEPTH * 2; ++i) zero_bf16(P, WSP(bf16, WS_CMP_W2) + (size_t)i * 256 * 256 + 64 * 256, (size_t)192 * 256);
        { const float* xs = INP(I_X); unsigned char* x8 = WSP(unsigned char, WS_XB8); const size_t nth = (size_t)P.G * 512, i0 = (size_t)P.bid * 512 + P.tid;
          for (size_t i = i0; i < (size_t)M * D / 8; i += nth) { const f32x4 a = *(const f32x4*)(xs + i * 8), b = *(const f32x4*)(xs + i * 8 + 4); *(u32x2*)(x8 + i * 8) = pk8_fp8(a, b); } }
        { const float* ms = INP(I_MEM); unsigned char* m8 = WSP(unsigned char, WS_MEMB); const size_t nth = (size_t)P.G * 512, i0 = (size_t)P.bid * 512 + P.tid;
          for (size_t i = i0; i < (size_t)BATCH * MEM_LEN * D / 8; i += nth) { const f32x4 a = *(const f32x4*)(ms + i * 8), b = *(const f32x4*)(ms + i * 8 + 4); *(u32x2*)(m8 + i * 8) = pk8_fp8(a, b); } }
        { const float* pe0 = INP(I_PE); const float* w10 = INP(I_CW1); float* CMP_B1 = WSP(float, WS_CMP_B1);
          for (int o = gw; o < DEPTH * 2 * 256; o += NGW) { const int lk = o >> 8, j = o & 255; const float* pe = pe0 + (size_t)lk * 2048; const float* w1 = w10 + (size_t)lk * 2048 * 256;
            float s = 0.f; for (int i = P.lane; i < 2048; i += 64) s += pe[i] * w1[(size_t)i * 256 + j];
            s = wave_sum(s); if (P.lane == 0) CMP_B1[o] = s; } }
    }
    SEAM(PH_CONV);
    layer_body<0>(F, bar, lo, hi);
    layer_body<1>(F, bar, lo, hi);
    static_assert(DEPTH == 2, "two layer copies");
}
#undef IN
#undef SEAM

extern "C" void kernel_launch(void* const* d_in, const int* in_sizes, int n_in, void* d_out, int out_size, void* d_ws, size_t ws_size, hipStream_t stream) {
    static int grid = 0;
    if (grid == 0) {
        if (n_in != 25 || in_sizes[0] != M * D || out_size != M * D || ws_size < WS_END) { fprintf(stderr, "kernel_launch: unexpected shapes: n_in %d in0 %d out %d ws %zu (need %zu)\n", n_in, n_in > 0 ? in_sizes[0] : -1, out_size, ws_size, (size_t)WS_END); grid = -1; return; }
        int dev = 0, cus = 0, per_cu = 0;
        if (hipGetDevice(&dev) != hipSuccess || hipDeviceGetAttribute(&cus, hipDeviceAttributeMultiprocessorCount, dev) != hipSuccess) { fprintf(stderr, "kernel_launch: device query failed\n"); grid = -1; return; }
        if (hipFuncSetAttribute((const void*)fwd, hipFuncAttributeMaxDynamicSharedMemorySize, LDS_BYTES) != hipSuccess) { fprintf(stderr, "kernel_launch: hipFuncSetAttribute failed\n"); grid = -1; return; }
        if (hipOccupancyMaxActiveBlocksPerMultiprocessor(&per_cu, (const void*)fwd, 512, LDS_BYTES) != hipSuccess || per_cu < 1) fprintf(stderr, "kernel_launch: occupancy query reports %d\n", per_cu);
        (void)hipGetLastError();
        grid = cus;
    }
    if (grid < 0) return;
    if (hipMemsetAsync((char*)d_ws + WS_CTL, 0, CTL_ZERO_BYTES, stream) != hipSuccess) { fprintf(stderr, "kernel_launch: memset failed\n"); return; }
    Args a{};
    for (int i = 0; i < 25; ++i) a.in[i] = (const float*)d_in[i];
    a.out = (float*)d_out; a.ws = (unsigned char*)d_ws;
#if N_LAUNCH_MODE == 1
    a.ph_lo = 0; a.ph_hi = N_PHASES;
    hipLaunchKernelGGL(fwd, dim3(grid), dim3(512), LDS_BYTES, stream, a);
#else
    for (int p = 0; p < N_PHASES; ++p) { a.ph_lo = p; a.ph_hi = p + 1; hipLaunchKernelGGL(fwd, dim3(grid), dim3(512), LDS_BYTES, stream, a); }
#endif
    const hipError_t le = hipPeekAtLastError();
    if (le != hipSuccess) fprintf(stderr, "kernel_launch: launch failed: %s\n", hipGetErrorName(le));
}
```

```cpp
#include <hip/hip_runtime.h>
#include <cstdio>
#include <cstdint>

#define LAS __attribute__((address_space(3)))
#define GAS __attribute__((address_space(1)))
typedef unsigned short bf16;
typedef short bf16x8 __attribute__((ext_vector_type(8)));
typedef float f32x4 __attribute__((ext_vector_type(4)));
typedef float f32x2 __attribute__((ext_vector_type(2)));
typedef unsigned u32x4 __attribute__((ext_vector_type(4)));
typedef unsigned u32x2 __attribute__((ext_vector_type(2)));
typedef int v8i32 __attribute__((ext_vector_type(8)));
typedef short s16x4 __attribute__((ext_vector_type(4)));

#define CONV_BLOCKS 96
#ifndef N_LAUNCH_MODE
#define N_LAUNCH_MODE 1
#endif

constexpr int D = 2048, BATCH = 8, SEQ = 2048, DEPTH = 2, M = BATCH * SEQ;
constexpr int MEM_LEN = 256;
constexpr int GLA_H = 4, GLA_DK = 128, GLA_DV = 256, GLA_RANK = 16, GLA_C = 64, GLA_NCH = SEQ / GLA_C;
constexpr int NSA_G = 4, NSA_DH = 64;
constexpr int N_EXP = 16, D_FF = 1536;
constexpr int D_IN = 9792, D_INP = 9984;
constexpr float DN_ALPHA = 1.4142135623730951f;
constexpr float LN_EPS = 1e-5f;
constexpr int MOE_MAXBLK = 144, MOE_P = MOE_MAXBLK * 256;

constexpr size_t MiB = 1u << 20;
constexpr size_t WS_CTL = 0, CTL_ZERO_BYTES = 1 * MiB;
constexpr size_t WS_W_IN = 2 * MiB;
constexpr size_t WS_W_BG = 80 * MiB;
constexpr size_t WS_W_BN = 88 * MiB;
constexpr size_t WS_W_OUT = 96 * MiB;
constexpr size_t WS_XA_WQ = 112 * MiB;
constexpr size_t WS_XA_WKV = 116 * MiB;
constexpr size_t WS_XA_WO = 124 * MiB;
constexpr size_t WS_CMP_W1 = 128 * MiB;
constexpr size_t WS_CMP_W2 = 132 * MiB;
constexpr size_t WS_CMP_B1 = 133 * MiB;
constexpr size_t WS_MOE_W1 = 134 * MiB;
constexpr size_t WS_MOE_W2 = 518 * MiB;
constexpr size_t WS_XB = 710 * MiB;
constexpr size_t WS_V = 774 * MiB;
constexpr size_t WS_XC = 902 * MiB;
constexpr size_t WS_GQ = 1030 * MiB;
constexpr size_t WS_GK = 1046 * MiB;
constexpr size_t WS_GV = 1062 * MiB;
constexpr size_t WS_GR = 1094 * MiB;
constexpr size_t WS_NQ = 1126 * MiB;
constexpr size_t WS_KC = 1158 * MiB;
constexpr size_t WS_KV4 = 1175 * MiB;
constexpr size_t WS_MG = 1207 * MiB;
constexpr size_t WS_GA = 1335 * MiB;
constexpr size_t WS_NG = 1336 * MiB;
constexpr size_t WS_UT = 1339 * MiB;
constexpr size_t WS_ST = 1467 * MiB;
constexpr size_t WS_DEC = 1531 * MiB;
constexpr size_t WS_OGLA = 1532 * MiB;
constexpr size_t WS_H1 = 1564 * MiB;
constexpr size_t WS_KCC = 1568 * MiB;
constexpr size_t WS_ONSA = 1569 * MiB;
constexpr size_t WS_M1 = 1601 * MiB;
constexpr size_t WS_XQ = 1665 * MiB;
constexpr size_t WS_XKV = 1681 * MiB;
constexpr size_t WS_MEMB = 1689 * MiB;
constexpr size_t WS_OXA = 1697 * MiB;
constexpr size_t WS_TOK = 1713 * MiB;
constexpr size_t WS_BUF = 1714 * MiB;
constexpr size_t WS_ACT = 1858 * MiB;
constexpr size_t WS_Y = 1966 * MiB;
constexpr size_t WS_XB8 = 2110 * MiB;
constexpr size_t WS_ST1 = 2142 * MiB;
constexpr size_t WS_ST2 = 2143 * MiB;
constexpr size_t WS_M8 = 2144 * MiB;
constexpr size_t WS_END = 2176 * MiB;

constexpr int CW_BAR = 4096;
constexpr int CW_CNT = 8192;
constexpr int CW_CONVQ = 8320;

constexpr int RING_BYTES = 131072;
constexpr int LDSCTL_OFF = RING_BYTES;
constexpr int MISC_OFF = LDSCTL_OFF + 320;
constexpr int MOETAB_OFF = LDSCTL_OFF + 512;
constexpr int PADST_OFF = LDSCTL_OFF + 1280;
constexpr int PTAB_OFF = LDSCTL_OFF + 2048;
constexpr int IPTAB_OFF = LDSCTL_OFF + 4096;
constexpr int ROWTOK_OFF = LDSCTL_OFF + 5120;
constexpr int LDS_BYTES = 147456;

__device__ __forceinline__ unsigned f2bf(float f) { unsigned u = __builtin_bit_cast(unsigned, f); return (u + 0x7fffu + ((u >> 16) & 1u)) >> 16; }
__device__ __forceinline__ float bf2f(unsigned h) { return __builtin_bit_cast(float, h << 16); }
__device__ __forceinline__ unsigned pk2(float lo, float hi) { return f2bf(lo) | (f2bf(hi) << 16); }
typedef __bf16 bf16x2_hw __attribute__((ext_vector_type(2)));
__device__ __forceinline__ unsigned cvt_pk_bf16(float lo, float hi) { const f32x2 v = {lo, hi}; return __builtin_bit_cast(unsigned, __builtin_convertvector(v, bf16x2_hw)); }
__device__ __forceinline__ u32x2 pk8_fp8(f32x4 a, f32x4 b) {
#pragma unroll
    for (int i = 0; i < 4; ++i) { a[i] = fminf(fmaxf(a[i], -448.f), 448.f); b[i] = fminf(fmaxf(b[i], -448.f), 448.f); }
    unsigned lo = 0u, hi = 0u;
    lo = (unsigned)__builtin_amdgcn_cvt_pk_fp8_f32(a[0], a[1], (int)lo, false); lo = (unsigned)__builtin_amdgcn_cvt_pk_fp8_f32(a[2], a[3], (int)lo, true);
    hi = (unsigned)__builtin_amdgcn_cvt_pk_fp8_f32(b[0], b[1], (int)hi, false); hi = (unsigned)__builtin_amdgcn_cvt_pk_fp8_f32(b[2], b[3], (int)hi, true);
    u32x2 r; r.x = lo; r.y = hi; return r;
}
__device__ __forceinline__ unsigned pk4_fp8(f32x4 a) {
#pragma unroll
    for (int i = 0; i < 4; ++i) a[i] = fminf(fmaxf(a[i], -448.f), 448.f);
    unsigned lo = 0u; lo = (unsigned)__builtin_amdgcn_cvt_pk_fp8_f32(a[0], a[1], (int)lo, false); lo = (unsigned)__builtin_amdgcn_cvt_pk_fp8_f32(a[2], a[3], (int)lo, true); return lo;
}
constexpr float W8_SCALE = 64.0f, W8_INV = 1.0f / 64.0f;
__device__ __forceinline__ f32x4 ld4_bf16(const bf16* p) { const u32x2 w = *(const u32x2*)p; return (f32x4){bf2f(w.x & 0xffffu), bf2f(w.x >> 16), bf2f(w.y & 0xffffu), bf2f(w.y >> 16)}; }
__device__ __forceinline__ void st4_bf16(bf16* p, f32x4 v) { u32x2 w; w.x = pk2(v[0], v[1]); w.y = pk2(v[2], v[3]); *(u32x2*)p = w; }
__device__ __forceinline__ float sigmoidf_(float x) { return 1.0f / (1.0f + __expf(-x)); }
__device__ __forceinline__ float siluf_(float x) { return x / (1.0f + __expf(-x)); }
__device__ __forceinline__ float gelu_tanh_(float x) { const float u = 1.5957691216057308f * (x + 0.044715f * x * x * x); return x / (1.0f + __expf(-u)); }
__device__ __forceinline__ float wave_sum(float v) {
#pragma unroll
    for (int o = 1; o < 64; o <<= 1) v += __shfl_xor(v, o);
    return v;
}
#define LDS_WAIT() asm volatile("s_waitcnt lgkmcnt(0)" ::: "memory")
#define VM_WAIT() asm volatile("s_waitcnt vmcnt(0)" ::: "memory")

namespace pg8 {
constexpr int BM = 256, BK = 64, HALF = 128, HTB = HALF * BK * 2, STAGE_BYTES = 8 * HTB, NXCD = 8, WGM = 8;
__host__ __device__ __forceinline__ int lds_byte(int r, int c) { const int st = (r >> 4) * 2 + (c >> 5), rr = r & 15, cc = c & 31, ob = rr * 64 + cc * 2; return st * 1024 + (ob ^ (((ob >> 9) & 1) << 5)); }
__host__ __device__ __forceinline__ void stage_rc(int b, int& R, int& C) { const int st = b / 1024, sb = b % 1024, swz = sb ^ (((sb >> 9) & 1) << 5); R = (st >> 1) * 16 + swz / 64; C = (st & 1) * 32 + (swz % 64) / 2; }
__host__ __device__ __forceinline__ int perm32(int rho) { const int n = rho >> 4, i = rho & 15; return 8 * (i >> 2) + 4 * n + (i & 3); }

struct Unit { int pm, pn, z; unsigned aoff, boff; };
struct Gemm { const bf16* A; const bf16* Bt; int lda, ldb, K; };

struct DenseOrder {
    static constexpr bool GATHER = false;
    int nM, nN, nZ, nwg, G, c, lda, ldb; unsigned azs, bzs;
    __device__ void init(int Mr, int Nc, int Z, int G_, int c_, int lda_, int ldb_, unsigned azs_, unsigned bzs_) { nM = Mr / BM; nN = Nc / BM; nZ = Z; nwg = nM * nN; G = G_; c = c_; lda = lda_; ldb = ldb_; azs = azs_; bzs = bzs_; }
    __device__ bool next(int i, Unit& u) const {
        const int L = i * G + c; if (c < 0 || L >= nwg * nZ) return false;
        const int z = L / nwg; int wgid = L % nwg;
        { const int q = nwg / NXCD, r = nwg % NXCD, xcd = wgid % NXCD, off = wgid / NXCD; wgid = (xcd < r ? xcd * (q + 1) : r * (q + 1) + (xcd - r) * q) + off; }
        const int nig = WGM * nN, gid = wgid / nig, fm = gid * WGM, gsz = (nM - fm) < WGM ? (nM - fm) : WGM;
        u.pm = fm + ((wgid % nig) % gsz); u.pn = (wgid % nig) / gsz; u.z = z;
        u.aoff = (unsigned)z * azs + (unsigned)u.pm * (unsigned)(BM * 2) * (unsigned)lda; u.boff = (unsigned)z * bzs + (unsigned)u.pn * (unsigned)(BM * 2) * (unsigned)ldb; return true;
    }
};
struct InProjOrder {
    static constexpr bool GATHER = false;
    DenseOrder d; int extra; unsigned a0, b0, a1, b1;
    __device__ bool next(int i, Unit& u) const {
        const int L = i * d.G + d.c;
        if (L < d.nwg) { const bool ok = d.next(i, u); u.aoff += a0; u.boff += b0; return ok; }
        const int e = L - d.nwg; if (e >= extra) return false;
        const int z = e >> 5, r = e & 31, pm = r & 7, pq = r >> 3;
        u.pm = pm; u.pn = 39 + z * 4 + pq; u.z = 0; u.aoff = a1 + (unsigned)pm * (unsigned)(BM * D); u.boff = b1 + (unsigned)z * (unsigned)(1024 * D) + (unsigned)pq * (unsigned)(BM * D); return true;
    }
};
template <bool GATHER_>
struct MoeOrderT {
    static constexpr bool GATHER = GATHER_;
    const LAS int* tab; int nN, G, c, lda, ldb; unsigned bzs;
    __device__ bool next(int i, Unit& u) const {
        const int L = i * G + c; const int nblk = __builtin_amdgcn_readfirstlane(tab[0]); if (L >= nblk * nN) return false;
        const int blk = L / nN, pn = L % nN, e = __builtin_amdgcn_readfirstlane(tab[16 + blk]);
        u.pm = blk; u.pn = pn; u.z = e; u.aoff = GATHER ? 0u : (unsigned)blk * (unsigned)(BM * 2) * (unsigned)lda; u.boff = (unsigned)e * bzs + (unsigned)pn * (unsigned)(BM * 2) * (unsigned)ldb; return true;
    }
};
typedef MoeOrderT<false> MoeOrder;
typedef MoeOrderT<true> MoeGatherOrder;

template <class Epi, class Sched, bool ALIGN_EPI>
__device__ __forceinline__ void gemm_phase(LAS unsigned char* lds, const int tid, const Gemm g, const Sched& S, const Epi& E) {
    const int wid = __builtin_amdgcn_readfirstlane(tid >> 6), lane = tid & 63, wr = wid >> 2, wc = wid & 3, fr = lane & 15, fq = lane >> 4;
    const int nt = g.K / BK;
    unsigned voffA[2], voffB[2];
#pragma unroll
    for (int i = 0; i < 2; ++i) { int R, C; const int b_ = tid * 16 + i * 8192;
        if (Epi::F8) { const int r7 = (b_ >> 7) & 7, gp = (b_ >> 4) & 7; R = 8 * (b_ >> 10) + r7; C = 8 * (gp ^ (((r7 >> 1) & 1) | (((r7 >> 2) & 1) << 2))); }
        else stage_rc(b_, R, C);
        const int Rb = Epi::PERM ? ((R & ~31) + perm32(R & 31)) : R;
        voffA[i] = (unsigned)(R * g.lda + C) * 2u; voffB[i] = (unsigned)(Rb * g.ldb + C) * 2u; }
    const size_t kstep = (size_t)(BK * 2);
    const size_t hsA = (size_t)HALF * g.lda * 2, hsB = (size_t)HALF * g.ldb * 2;
    const unsigned ldsw = (unsigned)wid * 1024u;
    constexpr bool F8 = Epi::F8;
    const int f8x = ((fr >> 1) & 1) | (((fr >> 2) & 1) << 2);
    const int aoff = F8 ? 128 * (wr * 64 + fr) + 16 * ((2 * fq) ^ f8x) : lds_byte(wr * 64 + fr, fq * 8), boff = F8 ? 128 * (wc * 32 + fr) + 16 * ((2 * fq) ^ f8x) : lds_byte(wc * 32 + fr, fq * 8);
    const int aoff1 = F8 ? 128 * (wr * 64 + fr) + 16 * ((2 * fq + 1) ^ f8x) : aoff + 1024, boff1 = F8 ? 128 * (wc * 32 + fr) + 16 * ((2 * fq + 1) ^ f8x) : boff + 1024;
#define PG8_SA(b, h) (((b) * 2 + (h)) * HTB)
#define PG8_SB(b, h) ((4 + (b) * 2 + (h)) * HTB)
#define PG8_STAGE(bufoff, gbase, voff) do { _Pragma("unroll") for (int _i = 0; _i < 2; ++_i) \
        __builtin_amdgcn_global_load_lds((const unsigned*)((const char*)(gbase) + (voff)[_i]), (LAS unsigned*)(lds + (bufoff) + ldsw + _i * 8192), 16, 0, 0); } while (0)
    constexpr bool GA = Sched::GATHER;
    unsigned ga[4] = {0u, 0u, 0u, 0u};
    const int grow = 8 * wid + ((tid >> 3) & 7); const unsigned gcb = 16u * (unsigned)((tid & 7) ^ ((((tid >> 3) & 7) >> 1 & 1) | ((((tid >> 3) & 7) >> 2 & 1) << 2)));
#define PG8_GLOAD(uidx) do { const LAS unsigned* rt_ = (const LAS unsigned*)(lds + ROWTOK_OFF) + (uidx) * 256 + grow; ga[0] = rt_[0] + gcb; ga[1] = rt_[64] + gcb; ga[2] = rt_[128] + gcb; ga[3] = rt_[192] + gcb; } while (0)
#define PG8_STAGE_A(bufoff, gbase, h) do { if constexpr (GA) PG8_STAGE(bufoff, gbase, ga + 2 * (h)); else PG8_STAGE(bufoff, (gbase) + (h) * hsA, voffA); } while (0)
#define PG8_LD8(dst, p0, p1) do { const u32x4 x0_ = *(const LAS u32x4*)(p0), x1_ = *(const LAS u32x4*)(p1); dst = (v8i32){(int)x0_.x, (int)x0_.y, (int)x0_.z, (int)x0_.w, (int)x1_.x, (int)x1_.y, (int)x1_.z, (int)x1_.w}; } while (0)
#define PG8_LDA(dst, b, h) do { _Pragma("unroll") for (int m = 0; m < 4; ++m) PG8_LD8(dst[m], lds + PG8_SA(b, h) + aoff + m * 2048, lds + PG8_SA(b, h) + aoff1 + m * 2048); } while (0)
#define PG8_LDB(dst, b, h) do { _Pragma("unroll") for (int n = 0; n < 2; ++n) PG8_LD8(dst[n], lds + PG8_SB(b, h) + boff + n * 2048, lds + PG8_SB(b, h) + boff1 + n * 2048); } while (0)
#define PG8_LO(v) __builtin_bit_cast(bf16x8, __builtin_shufflevector(v, v, 0, 1, 2, 3))
#define PG8_HI(v) __builtin_bit_cast(bf16x8, __builtin_shufflevector(v, v, 4, 5, 6, 7))
#define PG8_MMA(ai, bj, At, Bt) do { __builtin_amdgcn_s_setprio(1); _Pragma("unroll") for (int m = 0; m < 4; ++m) _Pragma("unroll") for (int n = 0; n < 2; ++n) { \
        if constexpr (F8) asm volatile("s_nop 1\n\tv_mfma_scale_f32_16x16x128_f8f6f4 %0, %1, %2, %0, %3, %3 op_sel_hi:[0,0,0]" : "+v"(acc[ai][bj][m][n]) : "v"(Bt[n]), "v"(At[m]), "v"(one_scale)); \
        else { acc[ai][bj][m][n] = __builtin_amdgcn_mfma_f32_16x16x32_bf16(PG8_LO(Bt[n]), PG8_LO(At[m]), acc[ai][bj][m][n], 0, 0, 0); \
               acc[ai][bj][m][n] = __builtin_amdgcn_mfma_f32_16x16x32_bf16(PG8_HI(Bt[n]), PG8_HI(At[m]), acc[ai][bj][m][n], 0, 0, 0); } } \
        __builtin_amdgcn_s_setprio(0); } while (0)
#define PG8_WAIT_V(n) asm volatile("s_waitcnt vmcnt(" #n ")" ::: "memory")
#define PG8_WAIT_L(n) asm volatile("s_waitcnt lgkmcnt(" #n ")" ::: "memory")
#define PG8_BAR __builtin_amdgcn_s_barrier()
#define PG8_SCHED __builtin_amdgcn_sched_barrier(0)
    Unit cur, nxt; int ui = 0;
    if (!S.next(0, cur)) return;
    f32x4 acc[2][2][4][2];
#pragma unroll
    for (int a = 0; a < 2; ++a)
#pragma unroll
        for (int b = 0; b < 2; ++b)
#pragma unroll
            for (int m = 0; m < 4; ++m)
#pragma unroll
                for (int n = 0; n < 2; ++n) acc[a][b][m][n] = (f32x4){0.f, 0.f, 0.f, 0.f};
    const int one_scale = 0x7f7f7f7f;
    v8i32 At[4], B0[2], B1[2];
    const char* cA = (const char*)g.A + cur.aoff; const char* cB = (const char*)g.Bt + cur.boff;
    if constexpr (GA) PG8_GLOAD(0);
    PG8_STAGE(PG8_SB(0, 0), cB, voffB); PG8_STAGE(PG8_SB(0, 1), cB + hsB, voffB); PG8_STAGE_A(PG8_SA(0, 0), cA, 0); PG8_STAGE_A(PG8_SA(0, 1), cA, 1);
    if (wr == 1) PG8_BAR;
    PG8_WAIT_V(2); PG8_BAR;
    PG8_STAGE(PG8_SB(1, 0), cB + kstep, voffB); PG8_STAGE_A(PG8_SA(1, 0), cA + kstep, 0); PG8_STAGE(PG8_SB(1, 1), cB + hsB + kstep, voffB);
    PG8_WAIT_V(6); PG8_BAR;
    for (;;) {
        const bool has_next = S.next(ui + 1, nxt);
        const char* nA = has_next ? (const char*)g.A + nxt.aoff : cA; const char* nB = has_next ? (const char*)g.Bt + nxt.boff : cB;
        for (int t = 0; t < nt; t += 2) {
            const bool last = (t == nt - 2);
            const char* a1 = cA + (size_t)(t + 1) * kstep;
            const char* a2 = last ? nA : cA + (size_t)(t + 2) * kstep; const char* b2 = last ? nB : cB + (size_t)(t + 2) * kstep;
            const char* a3 = a2 + kstep; const char* b3 = b2 + kstep;
            PG8_LDB(B0, 0, 0); PG8_LDB(B1, 0, 1); PG8_SCHED; PG8_LDA(At, 0, 0); PG8_STAGE_A(PG8_SA(1, 1), a1, 1);
            if constexpr (GA) { if (last && has_next) PG8_GLOAD(ui + 1); }
            PG8_WAIT_V(8); PG8_WAIT_L(0); PG8_BAR; PG8_MMA(0, 0, At, B0); PG8_MMA(0, 1, At, B1); PG8_BAR; PG8_SCHED;
            PG8_LDA(At, 0, 1); PG8_STAGE(PG8_SB(0, 0), b2, voffB); PG8_STAGE(PG8_SB(0, 1), b2 + hsB, voffB); PG8_STAGE_A(PG8_SA(0, 0), a2, 0);
            PG8_WAIT_V(8); PG8_WAIT_L(0); PG8_BAR; PG8_MMA(1, 0, At, B0); PG8_MMA(1, 1, At, B1); PG8_BAR; PG8_SCHED;
            PG8_LDB(B0, 1, 0); PG8_LDB(B1, 1, 1); PG8_SCHED; PG8_LDA(At, 1, 0); PG8_STAGE_A(PG8_SA(0, 1), a2, 1);
            PG8_WAIT_V(8); PG8_WAIT_L(0); PG8_BAR; PG8_MMA(0, 0, At, B0); PG8_MMA(0, 1, At, B1); PG8_BAR; PG8_SCHED;
            PG8_LDA(At, 1, 1); PG8_STAGE(PG8_SB(1, 0), b3, voffB); PG8_STAGE(PG8_SB(1, 1), b3 + hsB, voffB); PG8_STAGE_A(PG8_SA(1, 0), a3, 0);
            PG8_WAIT_V(8); PG8_WAIT_L(0); PG8_BAR; PG8_MMA(1, 0, At, B0); PG8_MMA(1, 1, At, B1); PG8_BAR; PG8_SCHED;
        }
        if constexpr (ALIGN_EPI) { if (wr == 0) PG8_BAR; }
        asm volatile("s_nop 15\n\ts_nop 15" ::: "memory");
        { int lo_ = lane; asm volatile("" : "+v"(lo_)); E(acc, cur, wr, wc, lo_ & 15, lo_ >> 4); }
        if (!has_next) break;
#pragma unroll
        for (int a = 0; a < 2; ++a)
#pragma unroll
            for (int b = 0; b < 2; ++b)
#pragma unroll
                for (int m = 0; m < 4; ++m)
#pragma unroll
                    for (int n = 0; n < 2; ++n) acc[a][b][m][n] = (f32x4){0.f, 0.f, 0.f, 0.f};
        cur = nxt; cA = nA; cB = nB; ++ui;
        if constexpr (ALIGN_EPI) { if (wr == 1) PG8_BAR; }
    }
    PG8_WAIT_V(0);
    if constexpr (!ALIGN_EPI) { if (wr == 0) PG8_BAR; }
    PG8_BAR;
#undef PG8_SA
#undef PG8_SB
#undef PG8_STAGE
#undef PG8_STAGE_A
#undef PG8_GLOAD
#undef PG8_LDA
#undef PG8_LD8
#undef PG8_LO
#undef PG8_HI
#undef PG8_LDB
#undef PG8_MMA
#undef PG8_WAIT_V
#undef PG8_WAIT_L
#undef PG8_BAR
#undef PG8_SCHED
}

struct EpiBf16 {
    static constexpr bool PERM = true; static constexpr bool F8 = false;
    bf16* O; int ldc; long zstride; int ncols;
    __device__ __forceinline__ void operator()(const f32x4 (&acc)[2][2][4][2], const Unit& u, int wr, int wc, int fr, int fq) const {
        const int row0 = u.pm * BM + wr * 64 + fr, col0 = u.pn * BM + wc * 32 + 8 * fq; bf16* base = O + (long)u.z * zstride;
#pragma unroll
        for (int ai = 0; ai < 2; ++ai)
#pragma unroll
            for (int m = 0; m < 4; ++m) { bf16* rowp = base + (size_t)(row0 + ai * HALF + m * 16) * ldc + col0;
#pragma unroll
                for (int bj = 0; bj < 2; ++bj) { if (col0 + bj * HALF < ncols) { const f32x4 v0 = acc[ai][bj][m][0], v1 = acc[ai][bj][m][1];
                    u32x4 w; w.x = cvt_pk_bf16(v0[0], v0[1]); w.y = cvt_pk_bf16(v0[2], v0[3]); w.z = cvt_pk_bf16(v1[0], v1[1]); w.w = cvt_pk_bf16(v1[2], v1[3]);
                    *(u32x4*)(rowp + bj * HALF) = w; } } }
    }
};
struct EpiCmp2 {
    static constexpr bool PERM = true; static constexpr bool F8 = false;
    bf16* O;
    __device__ __forceinline__ void operator()(const f32x4 (&acc)[2][2][4][2], const Unit& u, int wr, int wc, int fr, int fq) const {
        if (wc >= 2) return;
        const int row0 = u.pm * BM + wr * 64 + fr, col0 = wc * 32 + 8 * fq; bf16* base = O + (size_t)u.z * 4096 * 64;
#pragma unroll
        for (int ai = 0; ai < 2; ++ai)
#pragma unroll
            for (int m = 0; m < 4; ++m) { const f32x4 v0 = acc[ai][0][m][0], v1 = acc[ai][0][m][1];
                u32x4 w; w.x = cvt_pk_bf16(v0[0], v0[1]); w.y = cvt_pk_bf16(v0[2], v0[3]); w.z = cvt_pk_bf16(v1[0], v1[1]); w.w = cvt_pk_bf16(v1[2], v1[3]);
                *(u32x4*)(base + (size_t)(row0 + ai * HALF + m * 16) * 64 + col0) = w; }
    }
};
struct EpiCmp1 {
    static constexpr bool PERM = true; static constexpr bool F8 = true;
    bf16* O; const float* bias;
    __device__ __forceinline__ void operator()(const f32x4 (&acc)[2][2][4][2], const Unit& u, int wr, int wc, int fr, int fq) const {
        const int row0 = u.pm * BM + wr * 64 + fr, col0 = wc * 32 + 8 * fq; bf16* base = O + (size_t)u.z * 4096 * 256; const float* bz = bias + u.z * 256;
#pragma unroll
        for (int ai = 0; ai < 2; ++ai)
#pragma unroll
            for (int m = 0; m < 4; ++m) { bf16* rowp = base + (size_t)(row0 + ai * HALF + m * 16) * 256 + col0;
#pragma unroll
                for (int bj = 0; bj < 2; ++bj) { f32x4 v0 = acc[ai][bj][m][0] * W8_INV + *(const f32x4*)(bz + col0 + bj * HALF), v1 = acc[ai][bj][m][1] * W8_INV + *(const f32x4*)(bz + col0 + bj * HALF + 4);
#pragma unroll
                    for (int j = 0; j < 4; ++j) { v0[j] = gelu_tanh_(v0[j]); v1[j] = gelu_tanh_(v1[j]); }
                    u32x4 w; w.x = cvt_pk_bf16(v0[0], v0[1]); w.y = cvt_pk_bf16(v0[2], v0[3]); w.z = cvt_pk_bf16(v1[0], v1[1]); w.w = cvt_pk_bf16(v1[2], v1[3]);
                    *(u32x4*)(rowp + bj * HALF) = w; } }
    }
};
struct EpiInProj {
    static constexpr bool PERM = true; static constexpr bool F8 = true;
    GAS unsigned char* ws; const LAS unsigned* tab;
    __device__ __forceinline__ void operator()(const f32x4 (&acc)[2][2][4][2], const Unit& u, int wr, int wc, int fr, int fq) const {
        const int pn = u.pn; const int row0 = u.pm * BM + wr * 64 + fr; const int cl = wc * 32 + 8 * fq;
        if (pn == 38) {
            if (cl < 64) {
#pragma unroll
                for (int ai = 0; ai < 2; ++ai)
#pragma unroll
                    for (int m = 0; m < 4; ++m) { const int row = row0 + ai * HALF + m * 16; f32x4 v0 = acc[ai][0][m][0] * W8_INV, v1 = acc[ai][0][m][1] * W8_INV;
                        if (cl < 16) { GAS float* p = (GAS float*)(ws + WS_GA) + (size_t)row * 16 + cl; *(GAS f32x4*)p = v0; *(GAS f32x4*)(p + 4) = v1; }
                        else { GAS float* p = (GAS float*)(ws + WS_NG) + (size_t)row * 48 + (cl - 16);
#pragma unroll
                            for (int j = 0; j < 4; ++j) { v0[j] = sigmoidf_(v0[j]); v1[j] = sigmoidf_(v1[j]); }
                            *(GAS f32x4*)p = v0; *(GAS f32x4*)(p + 4) = v1; } }
            }
            return;
        }
        const LAS unsigned* te = tab + 4 * pn;
        const unsigned olo = __builtin_amdgcn_readfirstlane(te[0]), ohi = __builtin_amdgcn_readfirstlane(te[1]); const int ld = __builtin_amdgcn_readfirstlane(te[2]), mode = __builtin_amdgcn_readfirstlane(te[3]);
        GAS bf16* base = (GAS bf16*)(ws + (((unsigned long long)ohi << 32) | olo)); const int col = 0;
#pragma unroll
        for (int ai = 0; ai < 2; ++ai)
#pragma unroll
            for (int m = 0; m < 4; ++m) { const int row = row0 + ai * HALF + m * 16;
#pragma unroll
                for (int bj = 0; bj < 2; ++bj) { f32x4 v0 = acc[ai][bj][m][0] * W8_INV, v1 = acc[ai][bj][m][1] * W8_INV; const int c = cl + bj * HALF;
                    if (mode == 1) {
#pragma unroll
                        for (int j = 0; j < 4; ++j) { v0[j] = siluf_(v0[j]); v1[j] = siluf_(v1[j]); } }
                    if (mode == 2) {
#pragma unroll
                        for (int j = 0; j < 4; ++j) { v0[j] = sigmoidf_(v0[j]); v1[j] = sigmoidf_(v1[j]); } }
                    u32x4 w; w.x = cvt_pk_bf16(v0[0], v0[1]); w.y = cvt_pk_bf16(v0[2], v0[3]); w.z = cvt_pk_bf16(v1[0], v1[1]); w.w = cvt_pk_bf16(v1[2], v1[3]);
                    GAS bf16* p;
                    if (mode == 3) { const int gg = c >> 6, dd = c & 63, bb = row >> 11, tt = row & 2047; *(GAS u32x2*)((GAS unsigned char*)base + (((size_t)bb * 4 + gg) * 2048 + tt) * 64 + dd) = pk8_fp8(v0, v1); }
                    else { p = base + (size_t)row * ld + col + c; __builtin_nontemporal_store(w, (GAS u32x4*)p); } } }
    }
};
template <int STEP> struct EpiMerge {
    static constexpr bool PERM = true; static constexpr bool F8 = true;
    bf16* M1; const bf16* MG; unsigned char* M8;
    __device__ __forceinline__ void operator()(const f32x4 (&acc)[2][2][4][2], const Unit& u, int wr, int wc, int fr, int fq) const {
        const int row0 = u.pm * BM + wr * 64 + fr, col0 = u.pn * BM + wc * 32 + 8 * fq;
#pragma unroll
        for (int ai = 0; ai < 2; ++ai)
#pragma unroll
            for (int m = 0; m < 4; ++m) { const int row = row0 + ai * HALF + m * 16;
#pragma unroll
                for (int bj = 0; bj < 2; ++bj) { const int c = col0 + bj * HALF;
                    const u32x4 gw = *(const u32x4*)(MG + (size_t)row * 4096 + (STEP - 1) * 2048 + c);
                    f32x4 v0 = acc[ai][bj][m][0] * W8_INV, v1 = acc[ai][bj][m][1] * W8_INV;
                    v0[0] *= bf2f(gw.x & 0xffffu); v0[1] *= bf2f(gw.x >> 16); v0[2] *= bf2f(gw.y & 0xffffu); v0[3] *= bf2f(gw.y >> 16);
                    v1[0] *= bf2f(gw.z & 0xffffu); v1[1] *= bf2f(gw.z >> 16); v1[2] *= bf2f(gw.w & 0xffffu); v1[3] *= bf2f(gw.w >> 16);
                    bf16* p = M1 + (size_t)row * 2048 + c;
                    if (STEP == 2) { const u32x4 pw = *(const u32x4*)p;
                        v0[0] += bf2f(pw.x & 0xffffu); v0[1] += bf2f(pw.x >> 16); v0[2] += bf2f(pw.y & 0xffffu); v0[3] += bf2f(pw.y >> 16);
                        v1[0] += bf2f(pw.z & 0xffffu); v1[1] += bf2f(pw.z >> 16); v1[2] += bf2f(pw.w & 0xffffu); v1[3] += bf2f(pw.w >> 16); }
                    if (STEP == 2) *(u32x2*)(M8 + (size_t)row * 2048 + c) = pk8_fp8(v0, v1);
                    else { u32x4 w; w.x = cvt_pk_bf16(v0[0], v0[1]); w.y = cvt_pk_bf16(v0[2], v0[3]); w.z = cvt_pk_bf16(v1[0], v1[1]); w.w = cvt_pk_bf16(v1[2], v1[3]);
                        *(u32x4*)p = w; } } }
    }
};
template <bool F8_, bool XBF> struct EpiResid {
    static constexpr bool PERM = false; static constexpr bool F8 = F8_;
    const void* X; bf16* V;
    __device__ __forceinline__ void operator()(const f32x4 (&acc)[2][2][4][2], const Unit& u, int wr, int wc, int fr, int fq) const {
        const int row0 = u.pm * BM + wr * 64 + fr, col0 = u.pn * BM + wc * 32 + 4 * fq;
#pragma unroll
        for (int ai = 0; ai < 2; ++ai)
#pragma unroll
            for (int m = 0; m < 4; ++m) { const size_t off = (size_t)(row0 + ai * HALF + m * 16) * D + col0;
#pragma unroll
                for (int bj = 0; bj < 2; ++bj)
#pragma unroll
                    for (int n = 0; n < 2; ++n) { const size_t o = off + bj * HALF + n * 16; const f32x4 xv = XBF ? ld4_bf16((const bf16*)X + o) : *(const f32x4*)((const float*)X + o); st4_bf16(V + o, xv * DN_ALPHA + acc[ai][bj][m][n] * (F8_ ? W8_INV : 1.0f)); }
                asm volatile("" ::: "memory"); }
    }
};
template <bool F8_> struct EpiResidLN {
    static constexpr bool PERM = false; static constexpr bool F8 = F8_;
    bf16* V; const f32x2* stats; const float* g; const float* b;
    __device__ __forceinline__ void operator()(const f32x4 (&acc)[2][2][4][2], const Unit& u, int wr, int wc, int fr, int fq) const {
        const int row0 = u.pm * BM + wr * 64 + fr, col0 = u.pn * BM + wc * 32 + 4 * fq;
#pragma unroll
        for (int ai = 0; ai < 2; ++ai)
#pragma unroll
            for (int m = 0; m < 4; ++m) { const int row = row0 + ai * HALF + m * 16; const size_t off = (size_t)row * D + col0; const f32x2 st = stats[row]; const float ra = st[1] * DN_ALPHA, ma = -st[0] * ra;
#pragma unroll
                for (int bj = 0; bj < 2; ++bj)
#pragma unroll
                    for (int n = 0; n < 2; ++n) { const int c = bj * HALF + n * 16; const f32x4 xv = ld4_bf16(V + off + c), gg = *(const f32x4*)(g + col0 + c), bb = *(const f32x4*)(b + col0 + c);
                        st4_bf16(V + off + c, (xv * ra + ma) * gg + bb * DN_ALPHA + acc[ai][bj][m][n] * (F8_ ? W8_INV : 1.0f)); }
                asm volatile("" ::: "memory"); }
    }
};
struct EpiMoe1 {
    static constexpr bool PERM = true; static constexpr bool F8 = true;
    unsigned char* ACT;
    __device__ __forceinline__ void operator()(const f32x4 (&acc)[2][2][4][2], const Unit& u, int wr, int wc, int fr, int fq) const {
        const int row0 = u.pm * BM + wr * 64 + fr, col0 = u.pn * HALF + wc * 32 + 8 * fq;
#pragma unroll
        for (int ai = 0; ai < 2; ++ai)
#pragma unroll
            for (int m = 0; m < 4; ++m) { unsigned char* p = ACT + (size_t)(row0 + ai * HALF + m * 16) * D_FF + col0;
                f32x4 a0 = acc[ai][0][m][0] * W8_INV, a1 = acc[ai][0][m][1] * W8_INV; const f32x4 u0 = acc[ai][1][m][0] * W8_INV, u1 = acc[ai][1][m][1] * W8_INV;
#pragma unroll
                for (int j = 0; j < 4; ++j) { a0[j] = siluf_(a0[j]) * u0[j]; a1[j] = siluf_(a1[j]) * u1[j]; }
                *(u32x2*)p = pk8_fp8(a0, a1); }
    }
};
struct EpiBf16F8 {
    static constexpr bool PERM = true; static constexpr bool F8 = true;
    bf16* O; int ldc;
    __device__ __forceinline__ void operator()(const f32x4 (&acc)[2][2][4][2], const Unit& u, int wr, int wc, int fr, int fq) const {
        const int row0 = u.pm * BM + wr * 64 + fr, col0 = u.pn * BM + wc * 32 + 8 * fq;
#pragma unroll
        for (int ai = 0; ai < 2; ++ai)
#pragma unroll
            for (int m = 0; m < 4; ++m) { bf16* rowp = O + (size_t)(row0 + ai * HALF + m * 16) * ldc + col0;
#pragma unroll
                for (int bj = 0; bj < 2; ++bj) { const f32x4 v0 = acc[ai][bj][m][0] * W8_INV, v1 = acc[ai][bj][m][1] * W8_INV;
                    u32x4 w; w.x = cvt_pk_bf16(v0[0], v0[1]); w.y = cvt_pk_bf16(v0[2], v0[3]); w.z = cvt_pk_bf16(v1[0], v1[1]); w.w = cvt_pk_bf16(v1[2], v1[3]);
                    *(u32x4*)(rowp + bj * HALF) = w; } }
    }
};
struct EpiMoe2 {
    static constexpr bool PERM = true; static constexpr bool F8 = true;
    unsigned char* O;
    __device__ __forceinline__ void operator()(const f32x4 (&acc)[2][2][4][2], const Unit& u, int wr, int wc, int fr, int fq) const {
        const int row0 = u.pm * BM + wr * 64 + fr, col0 = u.pn * BM + wc * 32 + 8 * fq;
#pragma unroll
        for (int ai = 0; ai < 2; ++ai)
#pragma unroll
            for (int m = 0; m < 4; ++m) { unsigned char* rowp = O + (size_t)(row0 + ai * HALF + m * 16) * D + col0;
#pragma unroll
                for (int bj = 0; bj < 2; ++bj) *(u32x2*)(rowp + bj * HALF) = pk8_fp8(acc[ai][bj][m][0] * W8_INV, acc[ai][bj][m][1] * W8_INV); }
    }
};
}

#define XB_TMO      128
#define XB_XCNT(j)  (256  + 64 * (j))
#define XB_XSUB(j)  (1280 + 64 * (j))
#define XB_XGEN(j)  (2304 + 64 * (j))
#define XB_TOP      3328
#define XB_TOPGEN   3392
#define XCD_BAR_WORDS 3456
#define XB_SPIN_CAP (1u << 18)

__device__ __forceinline__ unsigned xb_ld(unsigned* p)              { return __hip_atomic_load(p, __ATOMIC_RELAXED, __HIP_MEMORY_SCOPE_AGENT); }
__device__ __forceinline__ unsigned xb_add(unsigned* p, unsigned v) { return __hip_atomic_fetch_add(p, v, __ATOMIC_RELAXED, __HIP_MEMORY_SCOPE_AGENT); }
__device__ __forceinline__ unsigned xb_xcc_id() { return (unsigned)__builtin_amdgcn_s_getreg((3 << 11) | 20) & 0xFu; }
#define XB_SPIN(cond, bar) do { unsigned _sp = 0; while (cond) { __builtin_amdgcn_s_sleep(1); \
    if ((++_sp & 255u) == 0u) { if (xb_ld(&(bar)[XB_TMO])) break; if (_sp > XB_SPIN_CAP) { atomicAdd(&(bar)[XB_TMO], 1u); break; } } } } while (0)

struct XcdBarrier { unsigned* bar; unsigned x; volatile LAS unsigned* st; };

__device__ __forceinline__ XcdBarrier xcd_barrier_post(unsigned* bar, volatile LAS unsigned* st) {
    XcdBarrier b; b.bar = bar; b.x = xb_xcc_id(); b.st = st;
    if (threadIdx.x == 0) (void)xb_add(&bar[XB_XCNT(b.x)], 1u);
    return b;
}
__device__ __forceinline__ void xcd_barrier_complete(unsigned* bar, unsigned x, unsigned& nloc, unsigned& nx) {
    const unsigned G = gridDim.x * gridDim.y * gridDim.z;
    unsigned sum, cnt, mine, sp = 0u;
    for (;;) {
        sum = 0u; cnt = 0u; mine = 0u;
#pragma unroll
        for (unsigned j = 0; j < 16; ++j) { const unsigned c = xb_ld(&bar[XB_XCNT(j)]); sum += c; cnt += (c > 0u) ? 1u : 0u; mine = (j == x) ? c : mine; }
        if (sum == G) break;
        __builtin_amdgcn_s_sleep(1);
        if ((++sp & 255u) == 0u) { if (xb_ld(&bar[XB_TMO])) break; if (sp > XB_SPIN_CAP) { atomicAdd(&bar[XB_TMO], 1u); break; } }
    }
    nloc = mine > 0u ? mine : 1u; nx = cnt > 0u ? cnt : 1u;
}
__device__ __forceinline__ void xcd_barrier(const XcdBarrier& b) {
    asm volatile("s_waitcnt vmcnt(0)" ::: "memory");
    __syncthreads();
    if (threadIdx.x == 0) {
        unsigned* bar = b.bar;
        __builtin_amdgcn_s_waitcnt(0);
        unsigned nloc = b.st[0], nx = b.st[1];
        if (nloc == 0u) { xcd_barrier_complete(bar, b.x, nloc, nx); b.st[0] = nloc; b.st[1] = nx; }
        const unsigned old = xb_add(&bar[XB_XSUB(b.x)], 1u);
        const unsigned gen = old / nloc;
        if (old + 1u == (gen + 1u) * nloc) {
            __builtin_amdgcn_fence(__ATOMIC_RELEASE, "agent");
            asm volatile("s_waitcnt vmcnt(0)" ::: "memory");
            const unsigned og = xb_add(&bar[XB_TOP], 1u);
            const unsigned tg = og / nx;
            if (og + 1u == (tg + 1u) * nx) xb_add(&bar[XB_TOPGEN], 1u);
            else XB_SPIN(xb_ld(&bar[XB_TOPGEN]) == tg, bar);
            __builtin_amdgcn_fence(__ATOMIC_ACQUIRE, "agent");
            xb_add(&bar[XB_XGEN(b.x)], 1u);
            asm volatile("s_waitcnt vmcnt(0)" ::: "memory");
        } else {
            XB_SPIN(xb_ld(&bar[XB_XGEN(b.x)]) == gen, bar);
            __builtin_amdgcn_fence(__ATOMIC_ACQUIRE, "agent");
            asm volatile("s_waitcnt vmcnt(0)" ::: "memory");
        }
    }
    __syncthreads();
}

struct Args { const float* in[25]; float* out; unsigned char* ws; int ph_lo, ph_hi; };
enum { I_X = 0, I_MEM, I_WIN, I_WA2, I_BA, I_GNG, I_PE, I_CW1, I_CW2, I_WBG, I_WBN, I_WOUT, I_LNMG, I_LNMB, I_XWQ, I_XWKV, I_XWO, I_LNXG, I_LNXB, I_RW, I_RB, I_MW1, I_MW2, I_LNFG, I_LNFB };
constexpr int PH_CONV = 0, PH_PRE2 = 1, PH_L0 = 2, PH_PER_LAYER = 17, N_PHASES = PH_L0 + DEPTH * PH_PER_LAYER;
enum { LP_INPROJ = 0, LP_A, LP_B, LP_GLA3, LP_NSA, LP_BG, LP_BN, LP_WOUT, LP_LN1, LP_XQ, LP_XATT, LP_WO, LP_LN2R, LP_DISP, LP_MOE1, LP_MOE2, LP_COMB };

struct Frame {
    LAS unsigned char* lds;
    int tid, lane, wave, G, bid;
};

__device__ __forceinline__ int map_inproj(int s) {
    if (s < 3072) return s;
    if (s < 3088) return 9728 + (s - 3072);
    if (s < 4112) return 3072 + (s - 3088);
    if (s < 5648) return 4096 + (s - 4112);
    if (s < 5696) return 9744 + (s - 5648);
    return 5632 + (s - 5696);
}
__device__ __forceinline__ int map_moe1(int s) { return s < 1536 ? ((s >> 7) * 256 + (s & 127)) : (((s - 1536) >> 7) * 256 + 128 + ((s - 1536) & 127)); }
template <int MAP> __device__ __forceinline__ int map_col(int s) { return MAP == 1 ? map_inproj(s) : (MAP == 2 ? map_moe1(s) : s); }
template <int MAP> __device__ __forceinline__ float col_scale(int s) { return MAP == 1 ? (s < 512 ? 0.08838834764831845f : ((s >= 3088 && s < 4112) ? 0.125f * 1.4426950408889634f : 1.0f)) : (MAP == 3 ? 0.08838834764831845f * 1.4426950408889634f : 1.0f); }

template <int MAP>
__device__ __forceinline__ void transpose_item(const float* W, int K, int N, bf16* WT, LAS float* scr, int item, int lane) {
    const int nblk = N / 32, kb = item / nblk, nb = item % nblk, k0 = 64 * kb, n0 = 32 * nb;
#pragma unroll
    for (int i = 0; i < 32; ++i) { const int kk = 2 * i + (lane >> 5); scr[kk * 33 + (lane & 31)] = W[(size_t)(k0 + kk) * N + n0 + (lane & 31)]; }
    LDS_WAIT();
    const int c = lane & 7;
#pragma unroll
    for (int j = 0; j < 4; ++j) { const int n = (lane >> 3) + 8 * j; const LAS float* s = scr + (8 * c) * 33 + n; const float cs = col_scale<MAP>(n0 + n);
        u32x4 o; o.x = pk2(s[0 * 33] * cs, s[1 * 33] * cs); o.y = pk2(s[2 * 33] * cs, s[3 * 33] * cs); o.z = pk2(s[4 * 33] * cs, s[5 * 33] * cs); o.w = pk2(s[6 * 33] * cs, s[7 * 33] * cs);
        *(u32x4*)(WT + (size_t)map_col<MAP>(n0 + n) * K + k0 + 8 * c) = o; }
    LDS_WAIT();
}
template <int MAP>
__device__ __forceinline__ void transpose_item_f8(const float* W, int K, int N, unsigned char* WT, LAS float* scr, int item, int lane) {
    const int nblk = N / 32, kb = item / nblk, nb = item % nblk, k0 = 64 * kb, n0 = 32 * nb;
#pragma unroll
    for (int i = 0; i < 32; ++i) { const int kk = 2 * i + (lane >> 5); scr[kk * 33 + (lane & 31)] = W[(size_t)(k0 + kk) * N + n0 + (lane & 31)]; }
    LDS_WAIT();
    const int c = lane & 7;
#pragma unroll
    for (int j = 0; j < 4; ++j) { const int n = (lane >> 3) + 8 * j; const LAS float* s = scr + (8 * c) * 33 + n; const float cs = col_scale<MAP>(n0 + n) * W8_SCALE;
        const f32x4 a = {s[0 * 33] * cs, s[1 * 33] * cs, s[2 * 33] * cs, s[3 * 33] * cs}, b = {s[4 * 33] * cs, s[5 * 33] * cs, s[6 * 33] * cs, s[7 * 33] * cs};
        *(u32x2*)(WT + (size_t)map_col<MAP>(n0 + n) * K + k0 + 8 * c) = pk8_fp8(a, b); }
    LDS_WAIT();
}
template <int MAP>
__device__ __forceinline__ void transpose_job_f8(const Frame& F, const float* W, int K, int N, int nmat, unsigned char* WT, size_t dstride) {
    LAS float* scr = (LAS float*)(F.lds + F.wave * 16384);
    const int gw = F.bid * 8 + F.wave, NGW = F.G * 8;
    const int ipm = (K / 64) * (N / 32); const long total = (long)ipm * nmat;
    for (long it = gw; it < total; it += NGW) { const int mi = (int)(it / ipm), r = (int)(it % ipm);
        transpose_item_f8<MAP>(W + (size_t)mi * K * N, K, N, WT + (size_t)mi * dstride, scr, r, F.lane); }
}
__device__ __forceinline__ void cvt_rows_bf16(const Frame& F, const float* src, bf16* dst, size_t n) {
    const size_t nth = (size_t)F.G * 512, i0 = (size_t)F.bid * 512 + F.tid;
    for (size_t i = i0; i < n / 8; i += nth) { const f32x4 a = *(const f32x4*)(src + i * 8), b = *(const f32x4*)(src + i * 8 + 4);
        u32x4 w; w.x = pk2(a[0], a[1]); w.y = pk2(a[2], a[3]); w.z = pk2(b[0], b[1]); w.w = pk2(b[2], b[3]); *(u32x4*)(dst + i * 8) = w; }
}
__device__ __forceinline__ void zero_bf16(const Frame& F, bf16* dst, size_t n) {
    const size_t nth = (size_t)F.G * 512, i0 = (size_t)F.bid * 512 + F.tid;
    for (size_t i = i0; i < n / 8; i += nth) *(u32x4*)(dst + i * 8) = (u32x4){0u, 0u, 0u, 0u};
}

constexpr int CJ0 = 32 * 306, CJ1 = 2 * 16 * 64, CJ2 = CJ1, CJ3 = 2 * 32 * 64, CJ4 = 2 * 32 * 16, CJ5 = 2 * 8 * 64, CJ6 = 4 * 32 * 8, CJ7 = 4 * 4 * 2, CJ8 = DEPTH * N_EXP * 32 * 96, CJ9 = DEPTH * N_EXP * 24 * 64;
constexpr int CONV_ITEMS = CJ0 + CJ1 + CJ2 + CJ3 + CJ4 + CJ5 + CJ6 + CJ7 + CJ8 + CJ9, CONV_CHUNK = 32, CONV_NCHUNK = (CONV_ITEMS + CONV_CHUNK - 1) / CONV_CHUNK;
struct ConvSrc { const float *win, *wbg, *wbn, *wout, *xwq, *xwo, *cw1, *cw2, *mw1, *mw2; GAS unsigned char* ws; };
struct ConvDesc { const float* W; int K, N, item, job, mi; };
__device__ __forceinline__ ConvDesc conv_desc(const ConvSrc& c, int f) {
    ConvDesc d;
    if (f < CJ0) { d.W = c.win + (size_t)D * D_IN; d.K = D; d.N = D_IN; d.item = f; d.job = 0; d.mi = 0; return d; } f -= CJ0;
    if (f < CJ1) { d.mi = f / (CJ1 / 2); d.item = f % (CJ1 / 2); d.W = c.wbg + (size_t)d.mi * 1024 * D; d.K = 1024; d.N = D; d.job = 1; return d; } f -= CJ1;
    if (f < CJ2) { d.mi = f / (CJ2 / 2); d.item = f % (CJ2 / 2); d.W = c.wbn + (size_t)d.mi * 1024 * D; d.K = 1024; d.N = D; d.job = 2; return d; } f -= CJ2;
    if (f < CJ3) { d.mi = f / (CJ3 / 2); d.item = f % (CJ3 / 2); d.W = c.wout + (size_t)d.mi * D * D; d.K = D; d.N = D; d.job = 3; return d; } f -= CJ3;
    if (f < CJ4) { d.mi = f / (CJ4 / 2); d.item = f % (CJ4 / 2); d.W = c.xwq + (size_t)d.mi * D * 512; d.K = D; d.N = 512; d.job = 4; return d; } f -= CJ4;
    if (f < CJ5) { d.mi = f / (CJ5 / 2); d.item = f % (CJ5 / 2); d.W = c.xwo + (size_t)d.mi * 512 * D; d.K = 512; d.N = D; d.job = 5; return d; } f -= CJ5;
    if (f < CJ6) { d.mi = f / (CJ6 / 4); d.item = f % (CJ6 / 4); d.W = c.cw1 + (size_t)d.mi * 2048 * 256; d.K = 2048; d.N = 256; d.job = 6; return d; } f -= CJ6;
    if (f < CJ7) { d.mi = f / (CJ7 / 4); d.item = f % (CJ7 / 4); d.W = c.cw2 + (size_t)d.mi * 256 * 64; d.K = 256; d.N = 64; d.job = 7; return d; } f -= CJ7;
    if (f < CJ8) { d.mi = f / (32 * 96); d.item = f % (32 * 96); d.W = c.mw1 + (size_t)d.mi * D * 2 * D_FF; d.K = D; d.N = 2 * D_FF; d.job = 8; return d; } f -= CJ8;
    d.mi = f / (24 * 64); d.item = f % (24 * 64); d.W = c.mw2 + (size_t)d.mi * D_FF * D; d.K = D_FF; d.N = D; d.job = 9; return d;
}
struct TileRegs { f32x4 v[8]; };
__device__ __forceinline__ void tile_load(const ConvDesc& d, int lane, TileRegs& r) {
    const int nblk = d.N / 32, kb = d.item / nblk, nb = d.item % nblk, k0 = 64 * kb + 8 * (lane >> 3), n0 = 32 * nb + 4 * (lane & 7);
    const float* p = d.W + (size_t)k0 * d.N + n0;
#pragma unroll
    for (int i = 0; i < 8; ++i) r.v[i] = __builtin_nontemporal_load((const f32x4*)(p + (size_t)i * d.N));
}
template <int MAP, bool F8>
__device__ __forceinline__ void tile_store(const TileRegs& r, int K, int N, void* WTv, LAS float* scr, int item, int lane) {
    const int nblk = N / 32, kb = item / nblk, nb = item % nblk, k0 = 64 * kb + 8 * (lane >> 3), n = 32 * nb + 4 * (lane & 7);
    const float cs = col_scale<MAP>(n) * (F8 ? W8_SCALE : 1.0f);
    const size_t row = (size_t)map_col<MAP>(n);
    if (F8) { unsigned char* p = (unsigned char*)WTv + row * K + k0;
#pragma unroll
        for (int c = 0; c < 4; ++c) { unsigned lo = 0u, hi = 0u;
            lo = (unsigned)__builtin_amdgcn_cvt_pk_fp8_f32(r.v[0][c] * cs, r.v[1][c] * cs, (int)lo, false); lo = (unsigned)__builtin_amdgcn_cvt_pk_fp8_f32(r.v[2][c] * cs, r.v[3][c] * cs, (int)lo, true);
            hi = (unsigned)__builtin_amdgcn_cvt_pk_fp8_f32(r.v[4][c] * cs, r.v[5][c] * cs, (int)hi, false); hi = (unsigned)__builtin_amdgcn_cvt_pk_fp8_f32(r.v[6][c] * cs, r.v[7][c] * cs, (int)hi, true);
            u32x2 w; w.x = lo; w.y = hi; *(u32x2*)(p + (size_t)c * K) = w; } }
    else { bf16* p = (bf16*)WTv + row * K + k0;
#pragma unroll
        for (int c = 0; c < 4; ++c) { u32x4 w; w.x = pk2(r.v[0][c] * cs, r.v[1][c] * cs); w.y = pk2(r.v[2][c] * cs, r.v[3][c] * cs); w.z = pk2(r.v[4][c] * cs, r.v[5][c] * cs); w.w = pk2(r.v[6][c] * cs, r.v[7][c] * cs);
            *(u32x4*)(p + (size_t)c * K) = w; } }
}
template <int MAP, bool F8>
__device__ __forceinline__ void convert_job(const Frame& F, const float* W, int K, int N, int nmat, void* WT, size_t dstride) {
    const int gw = F.bid * 8 + F.wave, NGW = F.G * 8;
    const int ipm = (K / 64) * (N / 32); const long total = (long)ipm * nmat;
    for (long it = gw; it < total; it += NGW) { ConvDesc d; d.mi = (int)(it / ipm); d.item = (int)(it % ipm); d.W = W + (size_t)d.mi * K * N; d.K = K; d.N = N; d.job = 0;
        TileRegs r; tile_load(d, F.lane, r);
        tile_store<MAP, F8>(r, K, N, F8 ? (void*)((unsigned char*)WT + (size_t)d.mi * dstride) : (void*)((bf16*)WT + (size_t)d.mi * dstride), nullptr, d.item, F.lane); }
}
constexpr int CT0 = 16 * 39, CT1 = 2 * 8 * 8, CT2 = CT1, CT3 = 2 * 16 * 8, CT4 = 2 * 16 * 2, CT5 = 2 * 4 * 8, CT6 = 4 * 16 * 1, CT8 = DEPTH * N_EXP * 16 * 12, CT9 = DEPTH * N_EXP * 12 * 8;
constexpr int CT_TOTAL = CT0 + CT1 + CT2 + CT3 + CT4 + CT5 + CT6 + CT8 + CT9, CT_CHUNK = 2, CT_NCHUNK = (CT_TOTAL + CT_CHUNK - 1) / CT_CHUNK;
constexpr int CT_PITCH = 144;
struct CTile { const float* W; unsigned char* WT; int K, N, map, kb, nb; };
__device__ __forceinline__ void ctile_split(int f, int KB, int NB, int& mi, int& kb, int& nb) { mi = f / (KB * NB); const int r = f % (KB * NB); kb = r / NB; nb = r % NB; }
__device__ __forceinline__ CTile ctile_desc(const ConvSrc& c, int f) {
    CTile t; int mi;
    if (f < CT0) { ctile_split(f, 16, 39, mi, t.kb, t.nb); t.W = c.win + (size_t)D * D_IN; t.WT = (unsigned char*)(c.ws + WS_W_IN) + (size_t)D_INP * D; t.K = D; t.N = D_IN; t.map = 1; return t; } f -= CT0;
    if (f < CT1) { ctile_split(f, 8, 8, mi, t.kb, t.nb); t.W = c.wbg + (size_t)mi * 1024 * D; t.WT = (unsigned char*)(c.ws + WS_W_BG) + (size_t)mi * D * 1024; t.K = 1024; t.N = D; t.map = 0; return t; } f -= CT1;
    if (f < CT2) { ctile_split(f, 8, 8, mi, t.kb, t.nb); t.W = c.wbn + (size_t)mi * 1024 * D; t.WT = (unsigned char*)(c.ws + WS_W_BN) + (size_t)mi * D * 1024; t.K = 1024; t.N = D; t.map = 0; return t; } f -= CT2;
    if (f < CT3) { ctile_split(f, 16, 8, mi, t.kb, t.nb); t.W = c.wout + (size_t)mi * D * D; t.WT = (unsigned char*)(c.ws + WS_W_OUT) + (size_t)mi * D * D; t.K = D; t.N = D; t.map = 0; return t; } f -= CT3;
    if (f < CT4) { ctile_split(f, 16, 2, mi, t.kb, t.nb); t.W = c.xwq + (size_t)mi * D * 512; t.WT = (unsigned char*)(c.ws + WS_XA_WQ) + (size_t)mi * 512 * D; t.K = D; t.N = 512; t.map = 3; return t; } f -= CT4;
    if (f < CT5) { ctile_split(f, 4, 8, mi, t.kb, t.nb); t.W = c.xwo + (size_t)mi * 512 * D; t.WT = (unsigned char*)(c.ws + WS_XA_WO) + (size_t)mi * D * 512; t.K = 512; t.N = D; t.map = 0; return t; } f -= CT5;
    if (f < CT6) { ctile_split(f, 16, 1, mi, t.kb, t.nb); t.W = c.cw1 + (size_t)mi * 2048 * 256; t.WT = (unsigned char*)(c.ws + WS_CMP_W1) + (size_t)mi * 256 * 2048; t.K = 2048; t.N = 256; t.map = 0; return t; } f -= CT6;
    if (f < CT8) { ctile_split(f, 16, 12, mi, t.kb, t.nb); t.W = c.mw1 + (size_t)mi * D * 2 * D_FF; t.WT = (unsigned char*)(c.ws + WS_MOE_W1) + (size_t)mi * 2 * D_FF * D; t.K = D; t.N = 2 * D_FF; t.map = 2; return t; } f -= CT8;
    ctile_split(f, 12, 8, mi, t.kb, t.nb); t.W = c.mw2 + (size_t)mi * D_FF * D; t.WT = (unsigned char*)(c.ws + WS_MOE_W2) + (size_t)mi * D * D_FF; t.K = D_FF; t.N = D; t.map = 0; return t;
}
__device__ __forceinline__ int map_col_rt(int map, int s) { return map == 1 ? map_inproj(s) : (map == 2 ? map_moe1(s) : s); }
__device__ __forceinline__ float col_scale_rt(int map, int s) { return map == 1 ? col_scale<1>(s) : (map == 3 ? col_scale<3>(s) : 1.0f); }
__device__ __forceinline__ void ctile_load(const CTile& t, int wave, int lane, f32x4 (&v)[16]) {
    const int n = 256 * t.nb + 4 * lane; const bool ok = n < t.N;
    const float* p = t.W + (size_t)(128 * t.kb + 16 * wave) * t.N + n;
#pragma unroll
    for (int i = 0; i < 16; ++i) { v[i] = (f32x4){0.f, 0.f, 0.f, 0.f}; if (ok) v[i] = __builtin_nontemporal_load((const f32x4*)(p + (size_t)i * t.N)); }
}
__device__ __forceinline__ void ctile_store(const CTile& t, const f32x4 (&v)[16], LAS unsigned char* tile, int tid, int wave, int lane) {
    const float cs = col_scale_rt(t.map, 256 * t.nb + 4 * lane) * W8_SCALE;
#pragma unroll
    for (int c = 0; c < 4; ++c) { unsigned w[4];
#pragma unroll
        for (int j = 0; j < 4; ++j) { unsigned x = 0u; x = (unsigned)__builtin_amdgcn_cvt_pk_fp8_f32(v[4 * j][c] * cs, v[4 * j + 1][c] * cs, (int)x, false); x = (unsigned)__builtin_amdgcn_cvt_pk_fp8_f32(v[4 * j + 2][c] * cs, v[4 * j + 3][c] * cs, (int)x, true); w[j] = x; }
        *(LAS u32x4*)(tile + (c * 64 + lane) * CT_PITCH + 16 * wave) = (u32x4){w[0], w[1], w[2], w[3]}; }
    __syncthreads();
#pragma unroll
    for (int j = 0; j < 4; ++j) { const int q = tid + 512 * j, g = q >> 3, nr = (g & 63) * 4 + (g >> 6), pc = q & 7, ncol = 256 * t.nb + nr;
        if (ncol < t.N) { const u32x4 w = *(const LAS u32x4*)(tile + g * CT_PITCH + 16 * pc); *(u32x4*)(t.WT + (size_t)map_col_rt(t.map, ncol) * t.K + 128 * t.kb + 16 * pc) = w; } }
    __syncthreads();
}
template <class NextFn, class DescFn>
__device__ __forceinline__ void ctile_run(const Frame& F, const int total, NextFn next, DescFn desc) {
    LAS unsigned char* tile = F.lds;
    const int fa = next();
    if (fa >= total) return;
    f32x4 A[16], B[16], C[16];
    CTile ta = desc(fa), tb = ta, tc = ta; ctile_load(ta, F.wave, F.lane, A);
    const int fb = next(); bool hb = fb < total, hc, ha;
    if (hb) { tb = desc(fb); ctile_load(tb, F.wave, F.lane, B); }
    for (;;) {
        { const int f = next(); hc = hb && f < total; if (hc) { tc = desc(f); ctile_load(tc, F.wave, F.lane, C); } }
        ctile_store(ta, A, tile, F.tid, F.wave, F.lane);
        if (!hb) break;
        { const int f = next(); ha = hc && f < total; if (ha) { ta = desc(f); ctile_load(ta, F.wave, F.lane, A); } }
        ctile_store(tb, B, tile, F.tid, F.wave, F.lane);
        if (!hc) break;
        { const int f = next(); hb = ha && f < total; if (hb) { tb = desc(f); ctile_load(tb, F.wave, F.lane, B); } }
        ctile_store(tc, C, tile, F.tid, F.wave, F.lane);
        if (!ha) break;
    }
}
__device__ __forceinline__ int conv_next(const Frame& F, unsigned* counter, int& ch, int& sub) {
    if (++sub < CT_CHUNK && ch >= 0) return ch * CT_CHUNK + sub;
    volatile LAS unsigned* MW = (volatile LAS unsigned*)(F.lds + MISC_OFF) + 16;
    if (F.tid == 0) MW[0] = __hip_atomic_fetch_add(counter, 1u, __ATOMIC_RELAXED, __HIP_MEMORY_SCOPE_AGENT);
    __syncthreads();
    ch = __builtin_amdgcn_readfirstlane((int)MW[0]); sub = 0;
    __syncthreads();
    return ch * CT_CHUNK;
}
__device__ __forceinline__ void conv_pull(const Frame& F, const ConvSrc& c, unsigned* counter) {
    if (F.bid == 0) {
        for (int f = F.wave; f < 32; f += 8) { ConvDesc d; d.mi = f / 8; d.item = f % 8; d.W = c.cw2 + (size_t)d.mi * 256 * 64; d.K = 256; d.N = 64; d.job = 7;
            TileRegs r; tile_load(d, F.lane, r); tile_store<0, false>(r, 256, 64, (bf16*)(c.ws + WS_CMP_W2) + (size_t)d.mi * 256 * 256, nullptr, d.item, F.lane); } }
    int ch = -1, sub = CT_CHUNK;
    ctile_run(F, CT_TOTAL, [&]() { return conv_next(F, counter, ch, sub); }, [&](int f) { return ctile_desc(c, f); });
}
__device__ __forceinline__ void row_load(const float* p, int lane, f32x4 (&v)[8]) {
#pragma unroll
    for (int j = 0; j < 8; ++j) v[j] = *(const f32x4*)(p + 4 * lane + 256 * j);
}
__device__ __forceinline__ void row_load_bf16(const bf16* p, int lane, f32x4 (&v)[8]) {
#pragma unroll
    for (int j = 0; j < 8; ++j) v[j] = ld4_bf16(p + 4 * lane + 256 * j);
}
__device__ __forceinline__ void row_ln(f32x4 (&v)[8], const float* g, const float* b, int lane) {
    float s = 0.f;
#pragma unroll
    for (int j = 0; j < 8; ++j) s += (v[j][0] + v[j][1]) + (v[j][2] + v[j][3]);
    const float mean = wave_sum(s) * (1.f / D); float s2 = 0.f;
#pragma unroll
    for (int j = 0; j < 8; ++j) { v[j] = v[j] - mean; s2 += (v[j][0] * v[j][0] + v[j][1] * v[j][1]) + (v[j][2] * v[j][2] + v[j][3] * v[j][3]); }
    const float rstd = 1.0f / sqrtf(wave_sum(s2) * (1.f / D) + LN_EPS);
#pragma unroll
    for (int j = 0; j < 8; ++j) { const f32x4 gg = *(const f32x4*)(g + 4 * lane + 256 * j), bb = *(const f32x4*)(b + 4 * lane + 256 * j); v[j] = v[j] * rstd * gg + bb; }
}
__device__ __forceinline__ f32x2 row_ln_stats(f32x4 (&v)[8], const float* g, const float* b, int lane) {
    float s = 0.f;
#pragma unroll
    for (int j = 0; j < 8; ++j) s += (v[j][0] + v[j][1]) + (v[j][2] + v[j][3]);
    const float mean = wave_sum(s) * (1.f / D); float s2 = 0.f;
#pragma unroll
    for (int j = 0; j < 8; ++j) { v[j] = v[j] - mean; s2 += (v[j][0] * v[j][0] + v[j][1] * v[j][1]) + (v[j][2] * v[j][2] + v[j][3] * v[j][3]); }
    const float rstd = 1.0f / sqrtf(wave_sum(s2) * (1.f / D) + LN_EPS);
#pragma unroll
    for (int j = 0; j < 8; ++j) { const f32x4 gg = *(const f32x4*)(g + 4 * lane + 256 * j), bb = *(const f32x4*)(b + 4 * lane + 256 * j); v[j] = v[j] * rstd * gg + bb; }
    f32x2 r; r[0] = mean; r[1] = rstd; return r;
}
__device__ __forceinline__ void row_store_bf16(bf16* pb, int lane, const f32x4 (&v)[8]) {
#pragma unroll
    for (int j = 0; j < 8; ++j) { u32x2 w; w.x = pk2(v[j][0], v[j][1]); w.y = pk2(v[j][2], v[j][3]); *(u32x2*)(pb + 4 * lane + 256 * j) = w; }
}
__device__ __forceinline__ void row_store_fp8(unsigned char* p8, int lane, const f32x4 (&v)[8]) {
#pragma unroll
    for (int j = 0; j < 8; ++j) *(unsigned*)(p8 + 4 * lane + 256 * j) = pk4_fp8(v[j]);
}
__device__ __forceinline__ void row_store(float* pf, bf16* pb, int lane, const f32x4 (&v)[8]) {
#pragma unroll
    for (int j = 0; j < 8; ++j) { *(f32x4*)(pf + 4 * lane + 256 * j) = v[j]; u32x2 w; w.x = pk2(v[j][0], v[j][1]); w.y = pk2(v[j][2], v[j][3]); *(u32x2*)(pb + 4 * lane + 256 * j) = w; }
}

__device__ __forceinline__ void row_store_bf16_f8(bf16* pb, unsigned char* p8, int lane, const f32x4 (&v)[8]) {
#pragma unroll
    for (int j = 0; j < 8; ++j) { st4_bf16(pb + 4 * lane + 256 * j, v[j]); *(unsigned*)(p8 + 4 * lane + 256 * j) = pk4_fp8(v[j]); }
}
__device__ __forceinline__ void row_store_f8(float* pf, unsigned char* p8, int lane, const f32x4 (&v)[8]) {
#pragma unroll
    for (int j = 0; j < 8; ++j) { *(f32x4*)(pf + 4 * lane + 256 * j) = v[j]; *(unsigned*)(p8 + 4 * lane + 256 * j) = pk4_fp8(v[j]); }
}
struct GlaCtx { int b, h, n, row0; };
__device__ __forceinline__ void gla_decay(const Frame& F, const GlaCtx& c, const float* GA, const float* wa2, const float* ba, float (&bcum)[16], float& blast) {
    LAS float* AL = (LAS float*)(F.lds + 0); LAS float* WA = (LAS float*)(F.lds + 4096); LAS float* SEG = (LAS float*)(F.lds + 12288);
    const int tid = F.tid;
    if (tid < 256) *(LAS f32x4*)(AL + tid * 4) = *(const f32x4*)(GA + (size_t)c.row0 * 16 + tid * 4);
    { const int r = tid >> 5, d4 = (tid & 31) * 4; *(LAS f32x4*)(WA + r * 128 + d4) = *(const f32x4*)(wa2 + r * 512 + c.h * 128 + d4); }
    __syncthreads();
    const int d = tid & 127, tq = tid >> 7;
    float wa[16];
#pragma unroll
    for (int r = 0; r < 16; ++r) wa[r] = WA[r * 128 + d];
    const float bias = ba[c.h * 128 + d];
    float run = 0.f;
#pragma unroll
    for (int i = 0; i < 16; ++i) { const int t = tq * 16 + i; float z = bias;
#pragma unroll
        for (int r = 0; r < 16; ++r) z += AL[t * 16 + r] * wa[r];
        const float ls = fminf(z, 0.f) - __logf(1.0f + __expf(-fabsf(z)));
        run += ls * (1.0f / 16.0f); bcum[i] = run; }
    SEG[tq * 128 + d] = run;
    __syncthreads();
    float off = 0.f, tot = 0.f;
#pragma unroll
    for (int q = 0; q < 4; ++q) { const float s = SEG[q * 128 + d]; tot += s; if (q < tq) off += s; }
#pragma unroll
    for (int i = 0; i < 16; ++i) bcum[i] += off;
    blast = tot;
}
__device__ __forceinline__ bf16x8 tr_frag(const LAS bf16* base, int stride, int row0, int col0, int lane) {
    const LAS bf16* p = base + (row0 + ((lane & 15) >> 2)) * stride + col0 + 4 * (lane & 3);
    const s16x4 a = __builtin_amdgcn_ds_read_tr16_b64_v4i16((LAS s16x4*)p), b = __builtin_amdgcn_ds_read_tr16_b64_v4i16((LAS s16x4*)(p + 4 * stride));
    return (bf16x8){a[0], a[1], a[2], a[3], b[0], b[1], b[2], b[3]};
}
__device__ __forceinline__ void gla_stage_vs(const Frame& F, const GlaCtx& c, const bf16* GV, LAS bf16* VS) {
#pragma unroll
    for (int k = 0; k < 4; ++k) { const int ch = F.tid + 512 * k, s = ch >> 5, e8 = (ch & 31) * 8;
        *(LAS u32x4*)(VS + s * 264 + e8) = *(const u32x4*)(GV + (size_t)(c.row0 + s) * 1024 + c.h * 256 + e8); }
}
__device__ __forceinline__ void gla_stage_vt(const Frame& F, const GlaCtx& c, const bf16* GV, LAS bf16* VT) {
#pragma unroll
    for (int k = 0; k < 4; ++k) { const int ch = F.tid + 512 * k, s = ch >> 5, e8 = (ch & 31) * 8;
        const u32x4 w = *(const u32x4*)(GV + (size_t)(c.row0 + s) * 1024 + c.h * 256 + e8);
        const unsigned ww[4] = {w.x, w.y, w.z, w.w};
#pragma unroll
        for (int j = 0; j < 4; ++j) { VT[(e8 + 2 * j) * 72 + s] = (bf16)(ww[j] & 0xffffu); VT[(e8 + 2 * j + 1) * 72 + s] = (bf16)(ww[j] >> 16); } }
}
__device__ __forceinline__ void gla_stage1(const Frame& F, int item, const float* GA, const float* wa2, const float* ba, const bf16* GK, const bf16* GV, bf16* UT, float* DEC) {
    GlaCtx c; c.b = item >> 7; c.h = (item >> 5) & 3; c.n = item & 31; c.row0 = c.b * SEQ + c.n * 64;
    LAS bf16* KH = (LAS bf16*)(F.lds + 14336); LAS bf16* VS = (LAS bf16*)(F.lds + 31744);
    gla_stage_vs(F, c, GV, VS);
    const int d = F.tid & 127, tq = F.tid >> 7;
    bf16 kraw[16];
#pragma unroll
    for (int i = 0; i < 16; ++i) kraw[i] = GK[(size_t)(c.row0 + tq * 16 + i) * 512 + c.h * 128 + d];
    float bcum[16], blast;
    gla_decay(F, c, GA, wa2, ba, bcum, blast);
#pragma unroll
    for (int i = 0; i < 16; ++i) { const int t = tq * 16 + i; KH[t * 136 + d] = (bf16)f2bf(bf2f(kraw[i]) * __expf(blast - bcum[i])); }
    if (tq == 0) DEC[(size_t)item * 128 + d] = __expf(blast);
    __syncthreads();
    const int w = F.wave, l15 = F.lane & 15, q = F.lane >> 4;
    bf16x8 af[2][2];
#pragma unroll
    for (int x = 0; x < 2; ++x)
#pragma unroll
        for (int ks = 0; ks < 2; ++ks) af[x][ks] = tr_frag(VS, 264, 32 * ks + 8 * q, 16 * (2 * w + x), F.lane);
    bf16* ut = UT + (size_t)item * 256 * 128;
#pragma unroll
    for (int dt = 0; dt < 8; ++dt) {
        bf16x8 bfr[2];
#pragma unroll
        for (int ks = 0; ks < 2; ++ks) bfr[ks] = tr_frag(KH, 136, 32 * ks + 8 * q, 16 * dt, F.lane);
#pragma unroll
        for (int x = 0; x < 2; ++x) { f32x4 acc = {0.f, 0.f, 0.f, 0.f};
#pragma unroll
            for (int ks = 0; ks < 2; ++ks) acc = __builtin_amdgcn_mfma_f32_16x16x32_bf16(bfr[ks], af[x][ks], acc, 0, 0, 0);
            u32x2 pw; pw.x = pk2(acc[0], acc[1]); pw.y = pk2(acc[2], acc[3]);
            *(u32x2*)(ut + (size_t)(16 * (2 * w + x) + l15) * 128 + 16 * dt + 4 * q) = pw; }
    }
    __syncthreads();
}
__device__ __forceinline__ void gla_scan(const Frame& F, int first_blk, int nblk, const bf16* UT, const float* DEC, bf16* ST) {
    const long nth = (long)nblk * 512, i0 = (long)(F.bid - first_blk) * 512 + F.tid;
    for (long idx = i0; idx < 32L * 256 * 32; idx += nth) {
        const int bh = (int)(idx >> 13), r = (int)(idx & 8191), e = r >> 5, d = (r & 31) * 4;
        f32x4 S = {0.f, 0.f, 0.f, 0.f};
        static_assert(GLA_NCH == 32, "eight batches of four chunks");
        const size_t item0 = (size_t)bh * 32, p0 = (item0 * 256 + e) * 128 + d;
        const bf16* up = UT + p0; bf16* sp = ST + p0; const float* dp = DEC + item0 * 128 + d;
        u32x2 uw[2][4]; f32x4 dc[2][4];
#pragma unroll
        for (int j = 0; j < 4; ++j) { dc[0][j] = *(const f32x4*)(dp + j * 128); uw[0][j] = *(const u32x2*)(up + (size_t)j * 256 * 128); }
#pragma unroll
        for (int nb = 0; nb < 8; ++nb) {
            if (nb + 1 < 8) {
#pragma unroll
                for (int j = 0; j < 4; ++j) { const int n = (nb + 1) * 4 + j; dc[(nb + 1) & 1][j] = *(const f32x4*)(dp + n * 128); uw[(nb + 1) & 1][j] = *(const u32x2*)(up + (size_t)n * 256 * 128); } }
#pragma unroll
            for (int j = 0; j < 4; ++j) { const int n = nb * 4 + j;
                u32x2 w; w.x = pk2(S[0], S[1]); w.y = pk2(S[2], S[3]); *(u32x2*)(sp + (size_t)n * 256 * 128) = w;
                const u32x2 u2 = uw[nb & 1][j]; const f32x4 uu = {bf2f(u2.x & 0xffffu), bf2f(u2.x >> 16), bf2f(u2.y & 0xffffu), bf2f(u2.y >> 16)}; S = dc[nb & 1][j] * S + uu; }
        }
    }
}
__device__ __forceinline__ void gla_stage3(const Frame& F, int item, const float* GA, const float* wa2, const float* ba, const float* gng, const bf16* GQ, const bf16* GK, const bf16* GV, const bf16* GR, const bf16* ST, bf16* OGLA) {
    GlaCtx c; c.b = item >> 7; c.h = (item >> 5) & 3; c.n = item & 31; c.row0 = c.b * SEQ + c.n * 64;
    LAS bf16* QS = (LAS bf16*)(F.lds + 14336); LAS bf16* KS = (LAS bf16*)(F.lds + 31744); LAS bf16* VS = (LAS bf16*)(F.lds + 49152); LAS bf16* PS = (LAS bf16*)(F.lds + 86016);
    LAS float* OS = (LAS float*)(F.lds + 0);
    gla_stage_vs(F, c, GV, VS);
    const int d = F.tid & 127, tq = F.tid >> 7;
    bf16 qraw[16], kraw[16];
#pragma unroll
    for (int i = 0; i < 16; ++i) { const size_t g = (size_t)(c.row0 + tq * 16 + i) * 512 + c.h * 128 + d; qraw[i] = GQ[g]; kraw[i] = GK[g]; }
    float bcum[16], blast;
    gla_decay(F, c, GA, wa2, ba, bcum, blast);
#pragma unroll
    for (int i = 0; i < 16; ++i) { const int t = tq * 16 + i;
        QS[t * 136 + d] = (bf16)f2bf(bf2f(qraw[i]) * __expf(bcum[i])); KS[t * 136 + d] = (bf16)f2bf(bf2f(kraw[i]) * __expf(-bcum[i])); }
    __syncthreads();
    const int w = F.wave, l15 = F.lane & 15, q = F.lane >> 4;
#pragma unroll
    for (int x = 0; x < 2; ++x) { const int tile = 2 * w + x, tt = tile >> 2, st = tile & 3; f32x4 acc = {0.f, 0.f, 0.f, 0.f};
        if (st <= tt) {
#pragma unroll
            for (int ks = 0; ks < 4; ++ks) { const bf16x8 a = *(const LAS bf16x8*)(QS + (16 * tt + l15) * 136 + 32 * ks + 8 * q), b = *(const LAS bf16x8*)(KS + (16 * st + l15) * 136 + 32 * ks + 8 * q);
                acc = __builtin_amdgcn_mfma_f32_16x16x32_bf16(a, b, acc, 0, 0, 0); } }
#pragma unroll
        for (int j = 0; j < 4; ++j) { const int t = 16 * tt + 4 * q + j, s = 16 * st + l15; PS[t * 72 + s] = (bf16)f2bf(s <= t ? acc[j] : 0.f); } }
    __syncthreads();
    f32x4 o[2][4];
    const bf16* st_item = ST + (size_t)item * 256 * 128;
#pragma unroll
    for (int x = 0; x < 2; ++x) { const int et = 2 * w + x;
        bf16x8 vf[2], sf[4];
#pragma unroll
        for (int ks = 0; ks < 2; ++ks) vf[ks] = tr_frag(VS, 264, 32 * ks + 8 * q, 16 * et, F.lane);
#pragma unroll
        for (int ks = 0; ks < 4; ++ks) sf[ks] = *(const bf16x8*)(st_item + (size_t)(16 * et + l15) * 128 + 32 * ks + 8 * q);
#pragma unroll
        for (int tt = 0; tt < 4; ++tt) { f32x4 acc = {0.f, 0.f, 0.f, 0.f};
#pragma unroll
            for (int ks = 0; ks < 2; ++ks) { const bf16x8 a = *(const LAS bf16x8*)(PS + (16 * tt + l15) * 72 + 32 * ks + 8 * q); acc = __builtin_amdgcn_mfma_f32_16x16x32_bf16(a, vf[ks], acc, 0, 0, 0); }
#pragma unroll
            for (int ks = 0; ks < 4; ++ks) { const bf16x8 a = *(const LAS bf16x8*)(QS + (16 * tt + l15) * 136 + 32 * ks + 8 * q); acc = __builtin_amdgcn_mfma_f32_16x16x32_bf16(a, sf[ks], acc, 0, 0, 0); }
            o[x][tt] = acc; } }
    __syncthreads();
#pragma unroll
    for (int x = 0; x < 2; ++x)
#pragma unroll
        for (int tt = 0; tt < 4; ++tt)
#pragma unroll
            for (int j = 0; j < 4; ++j) OS[(16 * tt + 4 * q + j) * 260 + 16 * (2 * w + x) + l15] = o[x][tt][j];
    __syncthreads();
    const f32x4 gn = *(const f32x4*)(gng + c.h * 256 + 4 * F.lane);
#pragma unroll
    for (int r = 0; r < 8; ++r) { const int t = 8 * w + r; f32x4 v = *(const LAS f32x4*)(OS + t * 260 + 4 * F.lane);
        const float mean = wave_sum((v[0] + v[1]) + (v[2] + v[3])) * (1.f / 256.f); v = v - mean;
        const float var = wave_sum((v[0] * v[0] + v[1] * v[1]) + (v[2] * v[2] + v[3] * v[3])) * (1.f / 256.f); const float rstd = 1.0f / sqrtf(var + LN_EPS);
        const size_t g = (size_t)(c.row0 + t) * 1024 + c.h * 256 + 4 * F.lane; const u32x2 rw = *(const u32x2*)(GR + g);
        v = v * rstd * gn; v[0] *= bf2f(rw.x & 0xffffu); v[1] *= bf2f(rw.x >> 16); v[2] *= bf2f(rw.y & 0xffffu); v[3] *= bf2f(rw.y >> 16);
        *(unsigned*)((unsigned char*)OGLA + g) = pk4_fp8(v); }
    __syncthreads();
}

template <int DH> struct FlashSt { f32x4 o[2][DH / 16]; f32x4 la[2]; float m[2]; };
template <int DH> __device__ __forceinline__ void flash_init(FlashSt<DH>& s) {
#pragma unroll
    for (int rt = 0; rt < 2; ++rt) {
#pragma unroll
        for (int dt = 0; dt < DH / 16; ++dt) s.o[rt][dt] = (f32x4){0.f, 0.f, 0.f, 0.f};
        s.m[rt] = -1e30f; s.la[rt] = (f32x4){0.f, 0.f, 0.f, 0.f}; }
}
template <int DH> __device__ __forceinline__ float flash_l(const FlashSt<DH>& s, int rt) { return s.la[rt][0]; }
template <int DH> struct FlashLds { static constexpr int KSTR = DH + 8, KT = 0, VT = 64 * KSTR * 2, BUFSZ = 2 * VT; };
template <int DH> struct KvRegs { u32x4 k[DH / 64], v[DH / 64]; };
template <int DH> __device__ __forceinline__ void kv_load(const Frame& F, const bf16* kg, int kstr, const bf16* vg, int vstr, KvRegs<DH>& r) {
#pragma unroll
    for (int k = 0; k < DH / 64; ++k) { const int ch = F.tid + 512 * k, key = ch / (DH / 8), c8 = (ch % (DH / 8)) * 8;
        r.k[k] = *(const u32x4*)(kg + (size_t)key * kstr + c8); r.v[k] = *(const u32x4*)(vg + (size_t)key * vstr + c8); }
}
template <int DH> __device__ __forceinline__ void kv_store(const Frame& F, LAS unsigned char* buf, const KvRegs<DH>& r, bool zero_last) {
    typedef FlashLds<DH> L; LAS bf16* KT = (LAS bf16*)(buf + L::KT); LAS bf16* VTt = (LAS bf16*)(buf + L::VT);
#pragma unroll
    for (int k = 0; k < DH / 64; ++k) { const int ch = F.tid + 512 * k, key = ch / (DH / 8), c8 = (ch % (DH / 8)) * 8;
        u32x4 kw = r.k[k], vw = r.v[k];
        if (zero_last && key == 63) { kw = (u32x4){0u, 0u, 0u, 0u}; vw = kw; }
        *(LAS u32x4*)(KT + key * L::KSTR + c8) = kw;
        *(LAS u32x4*)(VTt + key * L::KSTR + c8) = vw; }
}
template <int DH> __device__ __forceinline__ void flash_scores(const Frame& F, LAS unsigned char* buf, const bf16x8 (&qf)[2][DH / 32], f32x4 (&s)[2][4]) {
    typedef FlashLds<DH> L; const LAS bf16* KT = (const LAS bf16*)(buf + L::KT); const int l15 = F.lane & 15, q = F.lane >> 4;
#pragma unroll
    for (int ct = 0; ct < 4; ++ct) {
        bf16x8 kf[DH / 32];
#pragma unroll
        for (int ks = 0; ks < DH / 32; ++ks) kf[ks] = *(const LAS bf16x8*)(KT + (16 * ct + l15) * L::KSTR + 32 * ks + 8 * q);
#pragma unroll
        for (int rt = 0; rt < 2; ++rt) { f32x4 acc = {0.f, 0.f, 0.f, 0.f};
#pragma unroll
            for (int ks = 0; ks < DH / 32; ++ks) acc = __builtin_amdgcn_mfma_f32_16x16x32_bf16(kf[ks], qf[rt][ks], acc, 0, 0, 0);
            s[rt][ct] = acc; } }
}
struct TileMod { float base[2], step, lo[2], hi[2]; bool need_mask; };
template <int DH, bool PLAIN> __device__ __forceinline__ void flash_tile(const Frame& F, LAS unsigned char* buf, const bf16x8 (&qf)[2][DH / 32], FlashSt<DH>& st, const TileMod& tm, const float (&c0)[16]) {
    typedef FlashLds<DH> L; const LAS bf16* VTt = (const LAS bf16*)(buf + L::VT);
    const int l15 = F.lane & 15, q = F.lane >> 4;
    f32x4 s[2][4];
    flash_scores<DH>(F, buf, qf, s);
    __builtin_amdgcn_sched_barrier(0);
    bf16x8 pf[2][2];
    const float kq = (float)(4 * q);
    bool dead[2] = {false, false};
#pragma unroll
    for (int rt = 0; rt < 2; ++rt) {
        if (!PLAIN) { dead[rt] = __all(tm.base[rt] < -1.0e37f); }
        if (dead[rt]) { pf[rt][0] = (bf16x8){0, 0, 0, 0, 0, 0, 0, 0}; pf[rt][1] = pf[rt][0]; continue; }
        const float base = PLAIN ? 0.f : tm.base[rt];
        if (!PLAIN) {
#pragma unroll
            for (int ct = 0; ct < 4; ++ct)
#pragma unroll
                for (int j = 0; j < 4; ++j) s[rt][ct][j] += c0[ct * 4 + j];
            if (tm.need_mask) { const float lo = tm.lo[rt] - kq, hi = tm.hi[rt] - kq;
#pragma unroll
                for (int ct = 0; ct < 4; ++ct)
#pragma unroll
                    for (int j = 0; j < 4; ++j) { const float kk = (float)(16 * ct + j); s[rt][ct][j] = (kk >= lo && kk <= hi) ? s[rt][ct][j] : -3.0e38f; } }
        }
        float mx = -3.0e38f;
#pragma unroll
        for (int ct = 0; ct < 4; ++ct) mx = fmaxf(mx, fmaxf(fmaxf(s[rt][ct][0], s[rt][ct][1]), fmaxf(s[rt][ct][2], s[rt][ct][3])));
        mx = fmaxf(mx + base, -1e30f);
        mx = fmaxf(mx, __shfl_xor(mx, 16)); mx = fmaxf(mx, __shfl_xor(mx, 32));
        const bool grow = mx > st.m[rt] + 8.0f; const float mn = grow ? mx : st.m[rt];
        const float sh = mn - base;
#pragma unroll
        for (int ct = 0; ct < 4; ++ct)
#pragma unroll
            for (int j = 0; j < 4; ++j) s[rt][ct][j] = __builtin_amdgcn_exp2f(s[rt][ct][j] - sh);
        if (__any(grow)) { const float alpha = __builtin_amdgcn_exp2f(st.m[rt] - mn); st.la[rt] = st.la[rt] * alpha;
#pragma unroll
            for (int dt = 0; dt < DH / 16; ++dt) st.o[rt][dt] = st.o[rt][dt] * alpha; }
        st.m[rt] = mn;
#pragma unroll
        for (int ks = 0; ks < 2; ++ks) { u32x4 w; w.x = cvt_pk_bf16(s[rt][2 * ks][0], s[rt][2 * ks][1]); w.y = cvt_pk_bf16(s[rt][2 * ks][2], s[rt][2 * ks][3]);
            w.z = cvt_pk_bf16(s[rt][2 * ks + 1][0], s[rt][2 * ks + 1][1]); w.w = cvt_pk_bf16(s[rt][2 * ks + 1][2], s[rt][2 * ks + 1][3]); pf[rt][ks] = __builtin_bit_cast(bf16x8, w); }
    }
    __builtin_amdgcn_sched_barrier(0);
    { const bf16x8 ones = (bf16x8){0x3f80, 0x3f80, 0x3f80, 0x3f80, 0x3f80, 0x3f80, 0x3f80, 0x3f80};
#pragma unroll
      for (int rt = 0; rt < 2; ++rt) if (!dead[rt])
#pragma unroll
        for (int ks = 0; ks < 2; ++ks) st.la[rt] = __builtin_amdgcn_mfma_f32_16x16x32_bf16(ones, pf[rt][ks], st.la[rt], 0, 0, 0); }
#pragma unroll
    for (int dt = 0; dt < DH / 16; ++dt) {
        bf16x8 vf[2];
#pragma unroll
        for (int ks = 0; ks < 2; ++ks) { const LAS bf16* vp = VTt + (32 * ks + 4 * q + (l15 >> 2)) * L::KSTR + 16 * dt + 4 * (l15 & 3);
            const s16x4 a = __builtin_amdgcn_ds_read_tr16_b64_v4i16((LAS s16x4*)vp), b = __builtin_amdgcn_ds_read_tr16_b64_v4i16((LAS s16x4*)(vp + 16 * L::KSTR));
            vf[ks] = (bf16x8){a[0], a[1], a[2], a[3], b[0], b[1], b[2], b[3]}; }
#pragma unroll
        for (int rt = 0; rt < 2; ++rt) if (!dead[rt])
#pragma unroll
            for (int ks = 0; ks < 2; ++ks) st.o[rt][dt] = __builtin_amdgcn_mfma_f32_16x16x32_bf16(vf[ks], pf[rt][ks], st.o[rt][dt], 0, 0, 0);
    }
}
template <int DH, bool PLAIN, class MaskGen> __device__ __forceinline__ void flash_run(const Frame& F, LAS unsigned char* base, const bf16x8 (&qf)[2][DH / 32], FlashSt<DH>& st, unsigned bits,
                                                                          const bf16* kb, const bf16* vb, size_t tstride, int kstr, bool zero_tile1, const MaskGen& mg, int& buf, const KvRegs<DH> pre = KvRegs<DH>{}, const bool has_pre = false) {
    typedef FlashLds<DH> L;
    if (bits == 0u) return;
    int jb = __builtin_ctz(bits); bits &= bits - 1u;
    KvRegs<DH> r; if (has_pre) r = pre; else kv_load<DH>(F, kb + jb * tstride, kstr, vb + jb * tstride, kstr, r);
    float c0[16];
    { const float step = PLAIN ? 0.f : mg(jb).step; const float kq = (float)(4 * (F.lane >> 4));
#pragma unroll
      for (int i = 0; i < 16; ++i) c0[i] = step * ((float)(16 * (i >> 2) + (i & 3)) + kq); }
    for (;;) {
        kv_store<DH>(F, base + buf * L::BUFSZ, r, zero_tile1 && jb == 1);
        __syncthreads();
        const int jn = bits ? __builtin_ctz(bits) : -1;
        if (jn >= 0) { bits &= bits - 1u; kv_load<DH>(F, kb + jn * tstride, kstr, vb + jn * tstride, kstr, r); }
        flash_tile<DH, PLAIN>(F, base + buf * L::BUFSZ, qf, st, mg(jb), c0);
        buf ^= 1;
        if (jn < 0) break;
        jb = jn;
    }
}

struct NsaRowInfo { int t[2]; float slope2; };
struct GenNsa { NsaRowInfo ri; int mode, qb; unsigned selm[2];
    __device__ __forceinline__ TileMod operator()(int jb) const { TileMod m; const int k0 = 64 * jb;
        if (mode == 0) { m.step = 16.0f * ri.slope2; m.need_mask = true;
#pragma unroll
            for (int rt = 0; rt < 2; ++rt) { const float tt = (float)(ri.t[rt] - 16 * k0); m.base[rt] = -ri.slope2 * (tt - 15.5f); m.lo[rt] = -1.0f; m.hi[rt] = floorf((tt - 31.0f) * 0.0625f); } }
        else { m.step = ri.slope2; m.need_mask = (jb == qb) || (mode == 2 && jb + 8 <= qb);
#pragma unroll
            for (int rt = 0; rt < 2; ++rt) { const float tt = (float)(ri.t[rt] - k0); const bool rowok = mode == 2 || ((selm[rt] >> jb) & 1u);
                m.base[rt] = rowok ? -ri.slope2 * tt : -3.0e38f; m.hi[rt] = tt; m.lo[rt] = mode == 2 ? tt - 511.0f : -1.0f; } }
        return m; } };
struct GenNone { __device__ __forceinline__ TileMod operator()(int) const { TileMod m; m.base[0] = 0.f; m.base[1] = 0.f; m.step = 0.f; m.lo[0] = 0.f; m.lo[1] = 0.f; m.hi[0] = 0.f; m.hi[1] = 0.f; m.need_mask = false; return m; } };

__device__ __forceinline__ void nsa_unit(const Frame& F0, int unit, const bf16* NQ, const bf16* KCC, const bf16* KV4, const float* NG, bf16* ONSA) {
    Frame F = F0; { int t_ = F0.tid; asm volatile("" : "+v"(t_)); F.tid = t_; F.lane = t_ & 63; }
    const int b = unit >> 7, g = (unit >> 5) & 3, qb = unit & 31;
    LAS unsigned char* fb = F.lds;
    LAS float* PN = (LAS float*)(F.lds + 18432);
    LAS unsigned* SC = (LAS unsigned*)(F.lds + 52224);
    LAS unsigned* UM = (LAS unsigned*)(F.lds + 52480);
    LAS float* IMP = (LAS float*)(F.lds + 52736);
    LAS float* OT = (LAS float*)(F.lds + 61440) + F.wave * 2048 + F.lane;
    const int w = F.wave, l15 = F.lane & 15, q = F.lane >> 4;
    const size_t tok0 = (size_t)b * SEQ + 64 * qb;
    bf16x8 qf[2][2]; NsaRowInfo ri; size_t tokr[2];
    const int hh = l15 & 3;
#pragma unroll
    for (int rt = 0; rt < 2; ++rt) { const int tl = 8 * w + 4 * rt + (l15 >> 2); tokr[rt] = tok0 + tl; ri.t[rt] = 64 * qb + tl;
#pragma unroll
        for (int ks = 0; ks < 2; ++ks) qf[rt][ks] = *(const bf16x8*)(NQ + tokr[rt] * 1024 + g * 256 + hh * 64 + 32 * ks + 8 * q); }
    ri.slope2 = exp2f(-0.5f * (float)(4 * g + hh + 1)) * 1.4426950408889634f;
    float gts[2][3];
#pragma unroll
    for (int rt = 0; rt < 2; ++rt)
#pragma unroll
        for (int br = 0; br < 3; ++br) gts[rt][br] = NG[tokr[rt] * 48 + (g * 4 + hh) * 3 + br];
    if (F.tid == 0) UM[0] = 0u;
    FlashSt<64> st; int buf = 0;
    const bf16* kc = KCC + (size_t)(b * 4 + g) * 128 * 64; const bf16* vc = KCC + (size_t)4096 * 64 + (size_t)(b * 4 + g) * 128 * 64;
    const int ncmp_tiles = (4 * qb + 2 >= 64) ? 2 : 1;
    unsigned um = 0u; GenNsa gen; gen.ri = ri; gen.qb = qb; gen.selm[0] = 0u; gen.selm[1] = 0u;
#define NSA_ACCUM(br) do { _Pragma("unroll") for (int rt = 0; rt < 2; ++rt) { const float gt = gts[rt][(br)]; const float lr_ = flash_l<64>(st, rt); const float sc = lr_ > 0.f ? gt / lr_ : 0.f; \
        _Pragma("unroll") for (int dt = 0; dt < 4; ++dt) _Pragma("unroll") for (int j = 0; j < 4; ++j) { LAS float* o = OT + ((rt * 4 + dt) * 4 + j) * 64; const float v = st.o[rt][dt][j] * sc; *o = (br) == 0 ? v : *o + v; } } } while (0)
    gen.mode = 0;
    flash_init<64>(st);
    flash_run<64, false>(F, fb, qf, st, (1u << ncmp_tiles) - 1u, kc, vc, (size_t)64 * 64, 64, true, gen, buf);
    KvRegs<64> rp[2];
    kv_load<64>(F, kc, 64, vc, 64, rp[0]); if (ncmp_tiles == 2) kv_load<64>(F, kc + 64 * 64, 64, vc + 64 * 64, 64, rp[1]); else rp[1] = rp[0];
    NSA_ACCUM(0);
    __builtin_amdgcn_sched_barrier(0);
    __syncthreads();
#pragma unroll
    for (int ti = 0; ti < 2; ++ti) { if (ti < ncmp_tiles) {
        kv_store<64>(F, fb, rp[ti], ti == 1);
        __syncthreads();
        f32x4 s[2][4];
        flash_scores<64>(F, fb, qf, s);
        const TileMod tm = gen(ti); const float kq = (float)(4 * q);
#pragma unroll
        for (int rt = 0; rt < 2; ++rt) { const float lr_ = flash_l<64>(st, rt); const float inv = lr_ > 0.f ? 1.0f / lr_ : 0.f; const float b0 = tm.base[rt] + tm.step * kq - st.m[rt], hi = tm.hi[rt] - kq;
#pragma unroll
            for (int ct = 0; ct < 4; ++ct)
#pragma unroll
                for (int j = 0; j < 4; ++j) { const float kk = (float)(16 * ct + j); const float x = (s[rt][ct][j] + b0) + tm.step * kk; float p = kk <= hi ? __builtin_amdgcn_exp2f(x) * inv : 0.f;
                    p += __shfl_xor(p, 1); p += __shfl_xor(p, 2);
                    if (hh == 0) PN[(8 * w + 4 * rt + (l15 >> 2)) * 132 + 64 * ti + 16 * ct + 4 * q + j] = p; } }
        __syncthreads();
    } }
    { const int tl = F.tid >> 3, jj = F.tid & 7; float cv[4];
#pragma unroll
        for (int k = 0; k < 4; ++k) { const int j = jj + 8 * k; float a = -1.0f;
            if (j >= 1 && j <= qb - 2) { const int na = 4 * j - 1, nb = 4 * j + 3; a = 0.f; for (int n = na; n <= nb; ++n) a += PN[tl * 132 + n]; }
            cv[k] = a; }
        unsigned mask;
        if (qb + 1 <= 8) mask = (1u << (qb + 1)) - 1u;
        else { mask = 1u | (1u << qb) | (1u << (qb - 1));
#pragma unroll 1
            for (int it = 0; it < 5; ++it) { float bv = -1.0f; int bj = 64;
#pragma unroll
                for (int k = 0; k < 4; ++k) if (cv[k] > bv) { bv = cv[k]; bj = jj + 8 * k; }
#pragma unroll
                for (int off = 1; off < 8; off <<= 1) { const float ov = __shfl_xor(bv, off); const int oj = __shfl_xor(bj, off); if (ov > bv || (ov == bv && oj < bj)) { bv = ov; bj = oj; } }
                if (bv >= 0.f) { mask |= 1u << bj;
#pragma unroll
                    for (int k = 0; k < 4; ++k) if (jj + 8 * k == bj) cv[k] = -1.0f; } } }
        if (jj == 0) { SC[tl] = mask; atomicOr((unsigned*)UM, mask); } }
    __syncthreads();
    um = UM[0]; gen.selm[0] = SC[8 * w + (l15 >> 2)]; gen.selm[1] = SC[8 * w + 4 + (l15 >> 2)];
    buf = 0;
    __builtin_amdgcn_sched_barrier(0);
    const int j0 = qb - 8 < 0 ? 0 : qb - 8; const unsigned wbits = (qb == 31 ? 0xffffffffu : ((1u << (qb + 1)) - 1u)) & ~((1u << j0) - 1u);
    const bf16* ks_ = KV4 + ((size_t)b * SEQ) * 256 + g * 64;
    gen.mode = 1;
    flash_init<64>(st);
    flash_run<64, false>(F, fb, qf, st, um, ks_, ks_ + (size_t)M * 256, (size_t)64 * 256, 256, false, gen, buf);
    KvRegs<64> rw; kv_load<64>(F, ks_ + (size_t)2 * M * 256 + (size_t)j0 * 64 * 256, 256, ks_ + (size_t)3 * M * 256 + (size_t)j0 * 64 * 256, 256, rw);
    NSA_ACCUM(1);
    __builtin_amdgcn_sched_barrier(0);
    gen.mode = 2;
    flash_init<64>(st);
    flash_run<64, false>(F, fb, qf, st, wbits, ks_ + (size_t)2 * M * 256, ks_ + (size_t)3 * M * 256, (size_t)64 * 256, 256, false, gen, buf, rw, true);
    __builtin_amdgcn_sched_barrier(0);
#undef NSA_ACCUM
#pragma unroll
    for (int rt = 0; rt < 2; ++rt) { const float gt = gts[rt][2]; const float lr_ = flash_l<64>(st, rt); const float sc = lr_ > 0.f ? gt / lr_ : 0.f;
        unsigned char* p = (unsigned char*)ONSA + tokr[rt] * 1024 + g * 256 + hh * 64 + 4 * q;
#pragma unroll
        for (int dt = 0; dt < 4; ++dt) { float v[4];
#pragma unroll
            for (int j = 0; j < 4; ++j) v[j] = OT[((rt * 4 + dt) * 4 + j) * 64] + st.o[rt][dt][j] * sc;
            *(unsigned*)(p + 16 * dt) = pk4_fp8((f32x4){v[0], v[1], v[2], v[3]}); } }
    __syncthreads();
}

__device__ __forceinline__ void xattn_unit(const Frame& F, int unit, const bf16* XQ, const bf16* XKV, unsigned char* OXA) {
    const int b = unit >> 5, hd = (unit >> 3) & 3, qk = unit & 7;
    const int w = F.wave, l15 = F.lane & 15, q = F.lane >> 4;
    const size_t row0 = (size_t)b * SEQ + 256 * qk + 32 * w;
    bf16x8 qf[2][4];
#pragma unroll
    for (int rt = 0; rt < 2; ++rt)
#pragma unroll
        for (int ks = 0; ks < 4; ++ks) qf[rt][ks] = *(const bf16x8*)(XQ + (row0 + 16 * rt + l15) * 512 + hd * 128 + 32 * ks + 8 * q);
    FlashSt<128> st; flash_init<128>(st);
    GenNone gn; int buf = 0;
    const bf16* kg = XKV + ((size_t)b * 256) * 1024 + hd * 128;
    flash_run<128, true>(F, F.lds, qf, st, 0xFu, kg, kg + 512, (size_t)64 * 1024, 1024, false, gn, buf);
#pragma unroll
    for (int rt = 0; rt < 2; ++rt) { const float sc = 1.0f / flash_l<128>(st, rt); unsigned char* p = OXA + (row0 + 16 * rt + l15) * 512 + hd * 128 + 4 * q;
#pragma unroll
        for (int dt = 0; dt < 8; ++dt) *(unsigned*)(p + 16 * dt) = pk4_fp8(st.o[rt][dt] * sc); }
    __syncthreads();
}

__device__ __forceinline__ unsigned long long ptab_get(const Frame& F, int i) {
    const LAS unsigned* p = (const LAS unsigned*)(F.lds + PTAB_OFF) + 2 * i;
    const unsigned lo = __builtin_amdgcn_readfirstlane(p[0]), hi = __builtin_amdgcn_readfirstlane(p[1]);
    return ((unsigned long long)hi << 32) | lo;
}
#define INP(i) ((const float*)(GAS const float*)ptab_get(P, (i)))
#define WSB() ((unsigned char*)ptab_get(F, 26))
#define WSP(T, off) ((T*)(GAS T*)(wsb + (off)))
#define PHASE_FRAME() Frame P = F; { int t_ = F.wave * 64 + (int)__builtin_amdgcn_mbcnt_hi(~0u, __builtin_amdgcn_mbcnt_lo(~0u, 0u)); asm volatile("" : "+v"(t_)); P.tid = t_; P.lane = t_ & 63; P.wave = __builtin_amdgcn_readfirstlane(t_ >> 6); } GAS unsigned char* wsb = (GAS unsigned char*)ptab_get(P, 26)

#ifndef LPMASK
#define LPMASK 0xFFFFFFFFu
#endif
#ifndef GPMASK
#define GPMASK 3u
#endif
#define IN(k) (lo <= (k) && (k) < hi)
#define HAVEL(p) (((LPMASK) >> (p)) & 1u)
#ifndef REPMASK
#define REPMASK 0u
#endif
#define NREP(p) (1 + (int)(((REPMASK) >> (p)) & 1u))
#define HAVEG(p) (((GPMASK) >> (p)) & 1u)
#define SEAM(k) do { if (IN(k) && IN((k) + 1)) xcd_barrier(bar); } while (0)

template <int L> __device__ __forceinline__ void layer_body(const Frame& F, const XcdBarrier& bar, const int lo, const int hi) {
    constexpr int l = L;
    const int gw = F.bid * 8 + F.wave, NGW = F.G * 8;
        const int pb = PH_L0 + l * PH_PER_LAYER;
        if (HAVEL(LP_INPROJ) && IN(pb + LP_INPROJ)) for (int rep_ = 0; rep_ < NREP(LP_INPROJ); ++rep_) {
            PHASE_FRAME();
            pg8::Gemm g{(const bf16*)wsb, (const bf16*)wsb, D / 2, D / 2, D / 2};
            constexpr int NCV = (l == 0) ? CONV_BLOCKS : 0;
            pg8::InProjOrder S; S.d.init(M, D_INP, 1, P.G - NCV, P.bid - NCV, D / 2, D / 2, 0, 0); S.extra = (l == 0) ? 64 : 0;
            S.a0 = (unsigned)WS_XB8; S.b0 = (unsigned)(WS_W_IN + (size_t)l * D_INP * D); S.a1 = (unsigned)WS_MEMB; S.b1 = (unsigned)WS_XA_WKV;
            pg8::EpiInProj E{wsb, (const LAS unsigned*)(P.lds + IPTAB_OFF)};
            if (P.bid >= NCV) pg8::gemm_phase<pg8::EpiInProj, pg8::InProjOrder, true>(P.lds, P.tid, g, S, E);
            if (l == 0) { ConvSrc cs{INP(I_WIN), INP(I_WBG), INP(I_WBN), INP(I_WOUT), INP(I_XWQ), INP(I_XWO), INP(I_CW1), INP(I_CW2), INP(I_MW1), INP(I_MW2), wsb};
                conv_pull(P, cs, WSP(unsigned, WS_CTL) + CW_CONVQ); }
        }
        SEAM(pb + LP_INPROJ);
        const int ncmp = F.G >= 64 ? 32 : 0;
        if (HAVEL(LP_A) && IN(pb + LP_A)) for (int rep_ = 0; rep_ < NREP(LP_A); ++rep_) {
            PHASE_FRAME();
            if (P.bid < ncmp || ncmp == 0) {
                pg8::Gemm g{WSP(bf16, WS_KC), (const bf16*)(WSP(unsigned char, WS_CMP_W1) + (size_t)l * 2 * 256 * 2048), 512, 1024, 1024}; pg8::DenseOrder S; S.init(4096, 256, 2, ncmp ? ncmp : P.G, P.bid, 512, 1024, (unsigned)M * 256u, 256u * 2048u);
                pg8::EpiCmp1 E{WSP(bf16, WS_H1), WSP(float, WS_CMP_B1) + l * 512};
                pg8::gemm_phase<pg8::EpiCmp1, pg8::DenseOrder, true>(P.lds, P.tid, g, S, E);
            }
            if (P.bid >= ncmp) { const float* wa2 = INP(I_WA2) + (size_t)l * 16 * 512; const float* ba = INP(I_BA) + l * 512;
                for (int it = P.bid - ncmp; it < 1024; it += P.G - ncmp)
                    gla_stage1(P, it, WSP(float, WS_GA), wa2, ba, WSP(bf16, WS_GK), WSP(bf16, WS_GV), WSP(bf16, WS_UT), WSP(float, WS_DEC)); }
        }
        SEAM(pb + LP_A);
        if (HAVEL(LP_B) && IN(pb + LP_B)) for (int rep_ = 0; rep_ < NREP(LP_B); ++rep_) {
            PHASE_FRAME();
            if (P.bid < ncmp || ncmp == 0) {
                pg8::Gemm g{WSP(bf16, WS_H1), WSP(bf16, WS_CMP_W2) + (size_t)l * 2 * 256 * 256, 256, 256, 256}; pg8::DenseOrder S; S.init(4096, 256, 2, ncmp ? ncmp : P.G, P.bid, 256, 256, 4096u * 256u * 2u, 256u * 256u * 2u);
                pg8::EpiCmp2 E{WSP(bf16, WS_KCC)};
                pg8::gemm_phase<pg8::EpiCmp2, pg8::DenseOrder, true>(P.lds, P.tid, g, S, E);
            }
            if (P.bid >= ncmp) gla_scan(P, ncmp, P.G - ncmp, WSP(bf16, WS_UT), WSP(float, WS_DEC), WSP(bf16, WS_ST));
        }
        SEAM(pb + LP_B);
        if (HAVEL(LP_GLA3) && IN(pb + LP_GLA3)) for (int rep_ = 0; rep_ < NREP(LP_GLA3); ++rep_) {
            PHASE_FRAME();
            const float* wa2 = INP(I_WA2) + (size_t)l * 16 * 512; const float* ba = INP(I_BA) + l * 512; const float* gng = INP(I_GNG) + l * 1024;
            for (int it = P.bid; it < 1024; it += P.G)
                gla_stage3(P, it, WSP(float, WS_GA), wa2, ba, gng, WSP(bf16, WS_GQ), WSP(bf16, WS_GK), WSP(bf16, WS_GV), WSP(bf16, WS_GR), WSP(bf16, WS_ST), WSP(bf16, WS_OGLA));
        }
        if (IN(pb + LP_GLA3) && IN(pb + LP_GLA3 + 1)) __syncthreads();
        if (HAVEL(LP_NSA) && IN(pb + LP_NSA)) for (int rep_ = 0; rep_ < NREP(LP_NSA); ++rep_) {
            PHASE_FRAME();
            const int npair = (512 - P.bid + P.G - 1) / P.G;
            for (int k = 0; k < 2 * npair; ++k) { const int p0 = P.bid + (k >> 1) * P.G;
                const int p = (P.G == 256) ? ((P.bid & 7) * 64 + (k >> 1) * 32 + (P.bid >> 3)) : p0;
                const int bg = p >> 4, x = p & 15;
                nsa_unit(P, bg * 32 + ((k & 1) ? x : 31 - x), WSP(bf16, WS_NQ), WSP(bf16, WS_KCC), WSP(bf16, WS_KV4), WSP(float, WS_NG), WSP(bf16, WS_ONSA)); }
        }
        SEAM(pb + LP_NSA);
        if (HAVEL(LP_BG) && IN(pb + LP_BG)) for (int rep_ = 0; rep_ < NREP(LP_BG); ++rep_) {
            PHASE_FRAME();
            pg8::Gemm g{WSP(bf16, WS_OGLA), (const bf16*)(WSP(unsigned char, WS_W_BG) + (size_t)l * D * 1024), 512, 512, 512}; pg8::DenseOrder S; S.init(M, D, 1, P.G, P.bid, 512, 512, 0, 0);
            pg8::EpiMerge<1> E{WSP(bf16, WS_M1), WSP(bf16, WS_MG), WSP(unsigned char, WS_M8)};
            pg8::gemm_phase<pg8::EpiMerge<1>, pg8::DenseOrder, true>(P.lds, P.tid, g, S, E);
        }
        if (IN(pb + LP_BG) && IN(pb + LP_BG + 1)) { asm volatile("s_waitcnt vmcnt(0)" ::: "memory"); __syncthreads(); }
        if (HAVEL(LP_BN) && IN(pb + LP_BN)) {
            PHASE_FRAME();
            pg8::Gemm g{WSP(bf16, WS_ONSA), (const bf16*)(WSP(unsigned char, WS_W_BN) + (size_t)l * D * 1024), 512, 512, 512}; pg8::DenseOrder S; S.init(M, D, 1, P.G, P.bid, 512, 512, 0, 0);
            pg8::EpiMerge<2> E{WSP(bf16, WS_M1), WSP(bf16, WS_MG), WSP(unsigned char, WS_M8)};
            pg8::gemm_phase<pg8::EpiMerge<2>, pg8::DenseOrder, true>(P.lds, P.tid, g, S, E);
        }
        SEAM(pb + LP_BN);
        if (HAVEL(LP_WOUT) && IN(pb + LP_WOUT)) for (int rep_ = 0; rep_ < NREP(LP_WOUT); ++rep_) {
            PHASE_FRAME();
            pg8::Gemm g{(const bf16*)WSP(unsigned char, WS_M8), (const bf16*)(WSP(unsigned char, WS_W_OUT) + (size_t)l * D * D), D / 2, D / 2, D / 2}; pg8::DenseOrder S; S.init(M, D, 1, P.G, P.bid, D / 2, D / 2, 0, 0);
            if (l == 0) { pg8::EpiResid<true, false> E{(const void*)INP(I_X), WSP(bf16, WS_V)}; pg8::gemm_phase<pg8::EpiResid<true, false>, pg8::DenseOrder, true>(P.lds, P.tid, g, S, E); }
            else { pg8::EpiResid<true, true> E{(const void*)WSP(const bf16, WS_XC), WSP(bf16, WS_V)}; pg8::gemm_phase<pg8::EpiResid<true, true>, pg8::DenseOrder, true>(P.lds, P.tid, g, S, E); }
        }
        SEAM(pb + LP_WOUT);
        if (HAVEL(LP_LN1) && IN(pb + LP_LN1)) for (int rep_ = 0; rep_ < NREP(LP_LN1); ++rep_) {
            PHASE_FRAME();
            const float* gg = INP(I_LNMG) + l * D; const float* bb = INP(I_LNMB) + l * D; const bf16* V = WSP(const bf16, WS_V); unsigned char* X18 = WSP(unsigned char, WS_XB); f32x2* ST1 = WSP(f32x2, WS_ST1);
            for (int m = gw; m < M; m += 2 * NGW) { const int m2 = m + NGW; f32x4 v[8], w[8]; row_load_bf16(V + (size_t)m * D, P.lane, v); if (m2 < M) row_load_bf16(V + (size_t)m2 * D, P.lane, w);
                { const f32x2 st = row_ln_stats(v, gg, bb, P.lane); row_store_fp8(X18 + (size_t)m * D, P.lane, v); if (P.lane == 0) ST1[m] = st; }
                if (m2 < M) { const f32x2 st = row_ln_stats(w, gg, bb, P.lane); row_store_fp8(X18 + (size_t)m2 * D, P.lane, w); if (P.lane == 0) ST1[m2] = st; } }
        }
        SEAM(pb + LP_LN1);
        if (HAVEL(LP_XQ) && IN(pb + LP_XQ)) for (int rep_ = 0; rep_ < NREP(LP_XQ); ++rep_) {
            PHASE_FRAME();
            pg8::Gemm g{(const bf16*)WSP(unsigned char, WS_XB), (const bf16*)(WSP(unsigned char, WS_XA_WQ) + (size_t)l * 512 * D), D / 2, D / 2, D / 2}; pg8::DenseOrder S; S.init(M, 512, 1, P.G, P.bid, D / 2, D / 2, 0, 0);
            pg8::EpiBf16F8 E{WSP(bf16, WS_XQ), 512};
            pg8::gemm_phase<pg8::EpiBf16F8, pg8::DenseOrder, true>(P.lds, P.tid, g, S, E);
        }
        SEAM(pb + LP_XQ);
        if (HAVEL(LP_XATT) && IN(pb + LP_XATT)) for (int rep_ = 0; rep_ < NREP(LP_XATT); ++rep_) {
            PHASE_FRAME();
            for (int u = P.bid; u < 256; u += P.G) xattn_unit(P, u, WSP(bf16, WS_XQ), WSP(bf16, WS_XKV) + (size_t)l * BATCH * MEM_LEN * 1024, WSP(unsigned char, WS_OXA));
        }
        SEAM(pb + LP_XATT);
        if (HAVEL(LP_WO) && IN(pb + LP_WO)) for (int rep_ = 0; rep_ < NREP(LP_WO); ++rep_) {
            PHASE_FRAME();
            pg8::Gemm g{(const bf16*)WSP(unsigned char, WS_OXA), (const bf16*)(WSP(unsigned char, WS_XA_WO) + (size_t)l * D * 512), 256, 256, 256}; pg8::DenseOrder S; S.init(M, D, 1, P.G, P.bid, 256, 256, 0, 0);
            pg8::EpiResidLN<true> E{WSP(bf16, WS_V), WSP(const f32x2, WS_ST1), INP(I_LNMG) + l * D, INP(I_LNMB) + l * D};
            pg8::gemm_phase<pg8::EpiResidLN<true>, pg8::DenseOrder, true>(P.lds, P.tid, g, S, E);
        }
        const bool pre_rwt = IN(pb + LP_WO) && IN(pb + LP_LN2R);
        if (HAVEL(LP_LN2R) && pre_rwt) { PHASE_FRAME(); LAS float* RWT = (LAS float*)P.lds; const float* rw = INP(I_RW);
            for (int i = P.tid; i < D * N_EXP; i += 512) RWT[i] = rw[(i & (D - 1)) * N_EXP + (i >> 11)]; }
        SEAM(pb + LP_WO);
        if (HAVEL(LP_LN2R) && IN(pb + LP_LN2R)) {
            PHASE_FRAME();
            LAS float* RWT = (LAS float*)P.lds;
            const float* rw = INP(I_RW); const float* rb = INP(I_RB);
            if (!pre_rwt) { for (int i = P.tid; i < D * N_EXP; i += 512) RWT[i] = rw[(i & (D - 1)) * N_EXP + (i >> 11)]; }
            __syncthreads();
            const float* gg = INP(I_LNXG) + l * D; const float* bb = INP(I_LNXB) + l * D;
            const bf16* V = WSP(const bf16, WS_V); unsigned char* X28 = WSP(unsigned char, WS_XB); f32x2* ST2 = WSP(f32x2, WS_ST2); unsigned* TOK = WSP(unsigned, WS_TOK);
            unsigned* counts = WSP(unsigned, WS_CTL) + CW_CNT + l * 16;
            float rbl = 0.f; if (P.lane < 16) rbl = rb[P.lane];
            int cnt = 0;
            int r_e1 = 0, r_e2 = 0, r_p1 = 0, r_p2 = 0, r_m = -1; float r_g1 = 0.f, r_g2 = 0.f;
            int k = 0;
            for (int m = gw; m < M; m += NGW, ++k) {
                float mylg = 0.f;
                { f32x4 v[8]; row_load_bf16(V + (size_t)m * D, P.lane, v); const f32x2 st2 = row_ln_stats(v, gg, bb, P.lane); row_store_fp8(X28 + (size_t)m * D, P.lane, v); if (P.lane == 0) ST2[m] = st2;
                  float p[16];
#pragma unroll
                  for (int e = 0; e < 16; ++e) { float s = 0.f;
#pragma unroll
                    for (int j = 0; j < 8; ++j) { const f32x4 wv = *(const LAS f32x4*)(RWT + e * D + 4 * P.lane + 256 * j); s += (v[j][0] * wv[0] + v[j][1] * wv[1]) + (v[j][2] * wv[2] + v[j][3] * wv[3]); }
                    p[e] = s; __builtin_amdgcn_sched_barrier(0); }
#pragma unroll
                  for (int i = 0; i < 8; ++i) { const bool hi = (P.lane & 32) != 0; const float send = hi ? p[i] : p[i + 8], keep = hi ? p[i + 8] : p[i]; p[i] = keep + __shfl_xor(send, 32); }
#pragma unroll
                  for (int i = 0; i < 4; ++i) { const bool hi = (P.lane & 16) != 0; const float send = hi ? p[i] : p[i + 4], keep = hi ? p[i + 4] : p[i]; p[i] = keep + __shfl_xor(send, 16); }
#pragma unroll
                  for (int i = 0; i < 2; ++i) { const bool hi = (P.lane & 8) != 0; const float send = hi ? p[i] : p[i + 2], keep = hi ? p[i + 2] : p[i]; p[i] = keep + __shfl_xor(send, 8); }
                  { const bool hi = (P.lane & 4) != 0; const float send = hi ? p[0] : p[1], keep = hi ? p[1] : p[0]; p[0] = keep + __shfl_xor(send, 4); }
                  p[0] += __shfl_xor(p[0], 2); p[0] += __shfl_xor(p[0], 1);
                  mylg = p[0]; }
                float lg[16], lb[16];
#pragma unroll
                for (int e = 0; e < 16; ++e) { lg[e] = __shfl(mylg, ((e & 1) << 2) | ((e & 2) << 2) | ((e & 4) << 2) | ((e & 8) << 2)); lb[e] = lg[e] + __shfl(rbl, e); }
                float bs = -3.0e38f; int gb = 0;
#pragma unroll
                for (int gi = 0; gi < 4; ++gi) { float a1 = -3.0e38f, a2 = -3.0e38f;
#pragma unroll
                    for (int e = 0; e < 4; ++e) { const float x = lb[gi * 4 + e]; if (x > a1) { a2 = a1; a1 = x; } else if (x > a2) a2 = x; }
                    const float sc = a1 + a2; if (sc > bs) { bs = sc; gb = gi; } }
                float a1 = -3.0e38f, a2 = -3.0e38f; int i1 = 0, i2 = 0;
#pragma unroll
                for (int gi = 0; gi < 4; ++gi) if (gi == gb) {
#pragma unroll
                    for (int e = 0; e < 4; ++e) { const float x = lb[gi * 4 + e]; if (x > a1) { a2 = a1; i2 = i1; a1 = x; i1 = e; } else if (x > a2) { a2 = x; i2 = e; } } }
                const int e1 = gb * 4 + i1, e2 = gb * 4 + i2;
                float l1 = 0.f, l2 = 0.f;
#pragma unroll
                for (int e = 0; e < 16; ++e) { if (e == e1) l1 = lg[e]; if (e == e2) l2 = lg[e]; }
                const float g1 = 1.0f / (1.0f + __expf(l2 - l1)), g2 = 1.0f - g1;
                const int p1 = __shfl(cnt, e1), p2 = __shfl(cnt, e2);
                if (P.lane == e1 || P.lane == e2) cnt += 1;
                if (P.lane == k) { r_e1 = e1; r_e2 = e2; r_p1 = p1; r_p2 = p2; r_g1 = g1; r_g2 = g2; r_m = m; }
            }
            int base = 0;
            if (P.lane < 16 && cnt > 0) base = (int)__hip_atomic_fetch_add(counts + P.lane, (unsigned)cnt, __ATOMIC_RELAXED, __HIP_MEMORY_SCOPE_AGENT);
            const int b1 = __shfl(base, r_e1), b2 = __shfl(base, r_e2);
            if (r_m >= 0) { unsigned* INV = WSP(unsigned, WS_BUF);
                INV[(size_t)r_e1 * M + (b1 + r_p1)] = (unsigned)r_m; INV[(size_t)r_e2 * M + (b2 + r_p2)] = (unsigned)r_m; }
            if (r_m >= 0) { u32x4 a; a.x = (unsigned)r_e1; a.y = (unsigned)(b1 + r_p1); a.z = (unsigned)r_e2; a.w = (unsigned)(b2 + r_p2);
                u32x4 c; c.x = __builtin_bit_cast(unsigned, r_g1); c.y = __builtin_bit_cast(unsigned, r_g2); c.z = 0u; c.w = 0u;
                *(u32x4*)(TOK + (size_t)r_m * 8) = a; *(u32x4*)(TOK + (size_t)r_m * 8 + 4) = c; }
            __syncthreads();
        }
        SEAM(pb + LP_LN2R);
#define MOE_TABLE() do { if (P.tid == 0) { LAS int* tab = (LAS int*)(P.lds + MOETAB_OFF); LAS int* ps = (LAS int*)(P.lds + PADST_OFF); const unsigned* counts = WSP(unsigned, WS_CTL) + CW_CNT + l * 16; int nb = 0; \
            for (int e = 0; e < N_EXP; ++e) { const int c = (int)__hip_atomic_load(counts + e, __ATOMIC_RELAXED, __HIP_MEMORY_SCOPE_AGENT); const int k = (c + 255) >> 8; ps[e] = nb * 256; ps[16 + e] = c; for (int j = 0; j < k && nb < MOE_MAXBLK; ++j) tab[16 + nb++] = e; } \
            tab[0] = nb; } __syncthreads(); } while (0)
        if (HAVEL(LP_MOE1) && IN(pb + LP_MOE1)) for (int rep_ = 0; rep_ < NREP(LP_MOE1); ++rep_) {
            PHASE_FRAME();
            MOE_TABLE();
            { const LAS int* tab = (const LAS int*)(P.lds + MOETAB_OFF); const LAS int* ps = (const LAS int*)(P.lds + PADST_OFF); LAS unsigned* rt = (LAS unsigned*)(P.lds + ROWTOK_OFF); const unsigned* INV = WSP(const unsigned, WS_BUF);
              const int nblk = tab[0];
              for (int idx = P.tid; idx < 8 * 256; idx += 512) { const int Lu = (idx >> 8) * P.G + P.bid;
                  if (Lu < nblk * 12) { const int blk = Lu / 12, e = tab[16 + blk], c = ps[16 + e]; int pos = blk * 256 - ps[e] + (idx & 255); pos = pos < c ? pos : c - 1;
                      rt[idx] = INV[(size_t)e * M + pos] * (unsigned)D; } }
              __syncthreads(); }
            pg8::Gemm g{WSP(bf16, WS_XB), (const bf16*)(WSP(unsigned char, WS_MOE_W1) + (size_t)l * N_EXP * 2 * D_FF * D), D / 2, D / 2, D / 2};
            pg8::MoeGatherOrder S{(const LAS int*)(P.lds + MOETAB_OFF), 12, P.G, P.bid, D / 2, D / 2, 2u * D_FF * D};
            pg8::EpiMoe1 E{WSP(unsigned char, WS_ACT)};
            pg8::gemm_phase<pg8::EpiMoe1, pg8::MoeGatherOrder, true>(P.lds, P.tid, g, S, E);
        }
        SEAM(pb + LP_MOE1);
        if (HAVEL(LP_MOE2) && IN(pb + LP_MOE2)) for (int rep_ = 0; rep_ < NREP(LP_MOE2); ++rep_) {
            PHASE_FRAME();
            if (!IN(pb + LP_MOE1)) MOE_TABLE();
            pg8::Gemm g{WSP(bf16, WS_ACT), (const bf16*)(WSP(unsigned char, WS_MOE_W2) + (size_t)l * N_EXP * D * D_FF), D_FF / 2, D_FF / 2, D_FF / 2};
            pg8::MoeOrder S{(const LAS int*)(P.lds + MOETAB_OFF), 8, P.G, P.bid, D_FF / 2, D_FF / 2, (unsigned)D * D_FF};
            pg8::EpiMoe2 E{WSP(unsigned char, WS_Y)};
            pg8::gemm_phase<pg8::EpiMoe2, pg8::MoeOrder, true>(P.lds, P.tid, g, S, E);
        }
        SEAM(pb + LP_MOE2);
        if (HAVEL(LP_COMB) && IN(pb + LP_COMB)) {
            PHASE_FRAME();
            const float* gg = INP(I_LNFG) + l * D; const float* bb = INP(I_LNFB) + l * D;
            bf16* XC = WSP(bf16, WS_XC); unsigned char* X8 = WSP(unsigned char, WS_XB8); const unsigned* TOK = WSP(const unsigned, WS_TOK); const unsigned char* Y = WSP(const unsigned char, WS_Y);
            const bf16* Vp = WSP(const bf16, WS_V); const f32x2* ST2 = WSP(const f32x2, WS_ST2); const float* gxa = INP(I_LNXG) + l * D; const float* bxa = INP(I_LNXB) + l * D;
            float* outp = (float*)(GAS float*)ptab_get(P, 25);
            if (!IN(pb + LP_MOE1)) MOE_TABLE();
            const LAS int* ps = (const LAS int*)(P.lds + PADST_OFF);
            for (int m0 = gw; m0 < M; m0 += 2 * NGW) {
                u32x4 c[2], a4[2]; f32x4 v[2][8]; unsigned y1[2][8], y2[2][8];
#pragma unroll
                for (int r = 0; r < 2; ++r) { const int m = m0 + r * NGW; if (m < M) { c[r] = *(const u32x4*)(TOK + (size_t)m * 8 + 4); a4[r] = *(const u32x4*)(TOK + (size_t)m * 8); } else { c[r] = (u32x4){0u, 0u, 0u, 0u}; a4[r] = c[r]; } }
#pragma unroll
                for (int r = 0; r < 2; ++r) { const int m = m0 + r * NGW; if (m < M) {
#pragma unroll
                    for (int j = 0; j < 8; ++j) { const u32x2 w = __builtin_nontemporal_load((const u32x2*)(Vp + (size_t)m * D + 4 * P.lane + 256 * j)); v[r][j] = (f32x4){bf2f(w.x & 0xffffu), bf2f(w.x >> 16), bf2f(w.y & 0xffffu), bf2f(w.y >> 16)}; }
                    const size_t s1 = (size_t)(ps[a4[r].x] + (int)a4[r].y), s2 = (size_t)(ps[a4[r].z] + (int)a4[r].w);
#pragma unroll
                    for (int j = 0; j < 8; ++j) { y1[r][j] = __builtin_nontemporal_load((const unsigned*)(Y + s1 * D + 4 * P.lane + 256 * j)); y2[r][j] = __builtin_nontemporal_load((const unsigned*)(Y + s2 * D + 4 * P.lane + 256 * j)); } } }
#pragma unroll
                for (int r = 0; r < 2; ++r) { const int m = m0 + r * NGW; if (m < M) { const float g1 = __builtin_bit_cast(float, c[r].x), g2 = 1.0f - g1; const f32x2 st2 = ST2[m];
#pragma unroll
                    for (int j = 0; j < 8; ++j) { const f32x4 gx = *(const f32x4*)(gxa + 4 * P.lane + 256 * j), bx = *(const f32x4*)(bxa + 4 * P.lane + 256 * j); v[r][j] = (v[r][j] - st2[0]) * st2[1] * gx + bx; }
#pragma unroll
                    for (int j = 0; j < 8; ++j) { const unsigned a = y1[r][j], b = y2[r][j];
                        const f32x2 a01 = __builtin_amdgcn_cvt_pk_f32_fp8((int)a, false), a23 = __builtin_amdgcn_cvt_pk_f32_fp8((int)a, true), b01 = __builtin_amdgcn_cvt_pk_f32_fp8((int)b, false), b23 = __builtin_amdgcn_cvt_pk_f32_fp8((int)b, true);
                        v[r][j][0] = v[r][j][0] * DN_ALPHA + g1 * a01[0] + g2 * b01[0]; v[r][j][1] = v[r][j][1] * DN_ALPHA + g1 * a01[1] + g2 * b01[1];
                        v[r][j][2] = v[r][j][2] * DN_ALPHA + g1 * a23[0] + g2 * b23[0]; v[r][j][3] = v[r][j][3] * DN_ALPHA + g1 * a23[1] + g2 * b23[1]; }
                    row_ln(v[r], gg, bb, P.lane);
                    if (l == DEPTH - 1) {
#pragma unroll
                        for (int j = 0; j < 8; ++j) *(f32x4*)(outp + (size_t)m * D + 4 * P.lane + 256 * j) = v[r][j]; }
                    else row_store_bf16_f8(XC + (size_t)m * D, X8 + (size_t)m * D, P.lane, v[r]); } }
            }
        }
        SEAM(pb + LP_COMB);
    }

__global__ void __launch_bounds__(512, 2) fwd(Args args) {
    extern __shared__ __attribute__((aligned(16))) unsigned char lds_raw[];
    Frame F;
    F.lds = (LAS unsigned char*)lds_raw;
    F.tid = threadIdx.x; F.lane = F.tid & 63; F.wave = __builtin_amdgcn_readfirstlane(F.tid >> 6);
    F.G = gridDim.x; F.bid = blockIdx.x;
    for (int u = F.tid; u < (LDS_BYTES - LDSCTL_OFF) / 4; u += 512) ((LAS unsigned*)(F.lds + LDSCTL_OFF))[u] = 0u;
    __syncthreads();
    { LAS unsigned long long* PT = (LAS unsigned long long*)(F.lds + PTAB_OFF);
      if (F.tid < 25) PT[F.tid] = (unsigned long long)args.in[F.tid];
      if (F.tid == 25) PT[25] = (unsigned long long)args.out;
      if (F.tid == 26) PT[26] = (unsigned long long)args.ws; }
    if (F.tid >= 64 && F.tid < 64 + 38) { const int pn = F.tid - 64; unsigned long long off; unsigned ld, mode = 0u;
        if (pn < 2) { off = WS_GQ + (size_t)pn * 512; ld = 512; }
        else if (pn < 4) { off = WS_GK + (size_t)(pn - 2) * 512; ld = 512; }
        else if (pn < 8) { off = WS_GV + (size_t)(pn - 4) * 512; ld = 1024; }
        else if (pn < 12) { off = WS_GR + (size_t)(pn - 8) * 512; ld = 1024; mode = 1u; }
        else if (pn < 16) { off = WS_NQ + (size_t)(pn - 12) * 512; ld = 1024; }
        else if (pn < 18) { off = WS_KC + (size_t)(pn - 16) * M * 256; ld = 0; mode = 3u; }
        else if (pn < 22) { off = WS_KV4 + (size_t)(pn - 18) * M * 256 * 2; ld = 256; }
        else { off = WS_MG + (size_t)(pn - 22) * 512; ld = 4096; mode = 2u; }
        LAS unsigned* te = (LAS unsigned*)(F.lds + IPTAB_OFF) + 4 * pn; te[0] = (unsigned)off; te[1] = (unsigned)(off >> 32); te[2] = ld; te[3] = mode; }
    if (F.tid >= 128 && F.tid < 128 + 8) { const int e = F.tid - 128, z = e >> 2, pq = e & 3; const unsigned long long off = WS_XKV + (size_t)z * BATCH * MEM_LEN * 1024 * 2 + (size_t)pq * 512;
        LAS unsigned* te = (LAS unsigned*)(F.lds + IPTAB_OFF) + 4 * (39 + e); te[0] = (unsigned)off; te[1] = (unsigned)(off >> 32); te[2] = 1024u; te[3] = 0u; }
    __syncthreads();
    volatile LAS unsigned* MISC = (volatile LAS unsigned*)(F.lds + MISC_OFF);
    const int lo = args.ph_lo, hi = args.ph_hi;
    XcdBarrier bar; bar.bar = (unsigned*)(args.ws + WS_CTL) + CW_BAR; bar.x = 0; bar.st = nullptr;
    if (hi - lo > 1) bar = xcd_barrier_post((unsigned*)(args.ws + WS_CTL) + CW_BAR, MISC + 8);
    const int gw = F.bid * 8 + F.wave, NGW = F.G * 8;

    if (HAVEG(0) && IN(PH_CONV)) {
        PHASE_FRAME();
        { const float* win = INP(I_WIN); const float* xwkv = INP(I_XWKV); int it = P.bid;
          ctile_run(P, 624 + 128, [&]() { const int f = it; it += P.G; return f; },
              [&](int f) { CTile t; if (f < 624) { t.kb = f / 39; t.nb = f % 39; t.W = win; t.WT = WSP(unsigned char, WS_W_IN); t.K = D; t.N = D_IN; t.map = 1; }
                           else { const int r = f - 624, mi = r >> 6; t.kb = (r & 63) >> 2; t.nb = r & 3; t.W = xwkv + (size_t)mi * D * 1024; t.WT = WSP(unsigned char, WS_XA_WKV) + (size_t)mi * 1024 * D; t.K = D; t.N = 1024; t.map = 0; }
                           return t; });
          __syncthreads(); }
        for (int l = 0; l < DEPTH; ++l) zero_bf16(P, (bf16*)(WSP(unsigned char, WS_W_IN) + (size_t)l * D_INP * D + (size_t)D_IN * D), (size_t)(D_INP - D_IN) * D / 2);
        for (int i = 0; i < DEPTH * 2; ++i) zero_bf16(P, WSP(bf16, WS_CMP_W2) + (size_t)i * 256 * 256 + 64 * 256, (size_t)192 * 256);
        { const float* xs = INP(I_X); unsigned char* x8 = WSP(unsigned char, WS_XB8); const size_t nth = (size_t)P.G * 512, i0 = (size_t)P.bid * 512 + P.tid;
          for (size_t i = i0; i < (size_t)M * D / 8; i += nth) { const f32x4 a = *(const f32x4*)(xs + i * 8), b = *(const f32x4*)(xs + i * 8 + 4); *(u32x2*)(x8 + i * 8) = pk8_fp8(a, b); } }
        { const float* ms = INP(I_MEM); unsigned char* m8 = WSP(unsigned char, WS_MEMB); const size_t nth = (size_t)P.G * 512, i0 = (size_t)P.bid * 512 + P.tid;
          for (size_t i = i0; i < (size_t)BATCH * MEM_LEN * D / 8; i += nth) { const f32x4 a = *(const f32x4*)(ms + i * 8), b = *(const f32x4*)(ms + i * 8 + 4); *(u32x2*)(m8 + i * 8) = pk8_fp8(a, b); } }
        { const float* pe0 = INP(I_PE); const float* w10 = INP(I_CW1); float* CMP_B1 = WSP(float, WS_CMP_B1);
          for (int o = gw; o < DEPTH * 2 * 256; o += NGW) { const int lk = o >> 8, j = o & 255; const float* pe = pe0 + (size_t)lk * 2048; const float* w1 = w10 + (size_t)lk * 2048 * 256;
            float s = 0.f; for (int i = P.lane; i < 2048; i += 64) s += pe[i] * w1[(size_t)i * 256 + j];
            s = wave_sum(s); if (P.lane == 0) CMP_B1[o] = s; } }
    }
    SEAM(PH_CONV);
    layer_body<0>(F, bar, lo, hi);
    layer_body<1>(F, bar, lo, hi);
    static_assert(DEPTH == 2, "two layer copies");
}
#undef IN
#undef SEAM

extern "C" void kernel_launch(void* const* d_in, const int* in_sizes, int n_in, void* d_out, int out_size, void* d_ws, size_t ws_size, hipStream_t stream) {
    static int grid = 0;
    if (grid == 0) {
        if (n_in != 25 || in_sizes[0] != M * D || out_size != M * D || ws_size < WS_END) { fprintf(stderr, "kernel_launch: unexpected shapes: n_in %d in0 %d out %d ws %zu (need %zu)\n", n_in, n_in > 0 ? in_sizes[0] : -1, out_size, ws_size, (size_t)WS_END); grid = -1; return; }
        int dev = 0, cus = 0, per_cu = 0;
        if (hipGetDevice(&dev) != hipSuccess || hipDeviceGetAttribute(&cus, hipDeviceAttributeMultiprocessorCount, dev) != hipSuccess) { fprintf(stderr, "kernel_launch: device query failed\n"); grid = -1; return; }
        if (hipFuncSetAttribute((const void*)fwd, hipFuncAttributeMaxDynamicSharedMemorySize, LDS_BYTES) != hipSuccess) { fprintf(stderr, "kernel_launch: hipFuncSetAttribute failed\n"); grid = -1; return; }
        if (hipOccupancyMaxActiveBlocksPerMultiprocessor(&per_cu, (const void*)fwd, 512, LDS_BYTES) != hipSuccess || per_cu < 1) fprintf(stderr, "kernel_launch: occupancy query reports %d\n", per_cu);
        (void)hipGetLastError();
        grid = cus;
    }
    if (grid < 0) return;
    if (hipMemsetAsync((char*)d_ws + WS_CTL, 0, CTL_ZERO_BYTES, stream) != hipSuccess) { fprintf(stderr, "kernel_launch: memset failed\n"); return; }
    Args a{};
    for (int i = 0; i < 25; ++i) a.in[i] = (const float*)d_in[i];
    a.out = (float*)d_out; a.ws = (unsigned char*)d_ws;
#if N_LAUNCH_MODE == 1
    a.ph_lo = 0; a.ph_hi = N_PHASES;
    hipLaunchKernelGGL(fwd, dim3(grid), dim3(512), LDS_BYTES, stream, a);
#else
    for (int p = 0; p < N_PHASES; ++p) { a.ph_lo = p; a.ph_hi = p + 1; hipLaunchKernelGGL(fwd, dim3(grid), dim3(512), LDS_BYTES, stream, a); }
#endif
    const hipError_t le = hipPeekAtLastError();
    if (le != hipSuccess) fprintf(stderr, "kernel_launch: launch failed: %s\n", hipGetErrorName(le));
}
```
